# Optimizing an MI355X kernel written in HIP

```python
import math
import jax, jax.numpy as jnp
from jax import lax
import numpy as np

D_MODEL = 1024
BATCH = 2
SEQ = 8192
DEPTH = 1

MIX_WIDTH = D_MODEL
RET_WIDTH = MIX_WIDTH // 2
DIFF_WIDTH = MIX_WIDTH - RET_WIDTH
RET_HD = 64
N_RET_HEADS = RET_WIDTH // RET_HD
DIFF_VD = 128
N_DIFF_HEADS = DIFF_WIDTH // DIFF_VD
DIFF_HD = DIFF_VD // 2
RET_CHUNK = 128
Q_BLOCK = 128
ROPE_BASE = 10000.0
D_FF = ((8 * D_MODEL // 3 + 255) // 256) * 256
NORM_EPS = 1e-6
LAYER_INDEX = 1
LAMBDA_INIT = 0.8 - 0.6 * math.exp(-0.3 * (LAYER_INDEX - 1))
LAMBDA_STD = 0.1
IN_SPLITS = [RET_WIDTH, RET_WIDTH, RET_WIDTH, RET_WIDTH,
             N_DIFF_HEADS * 2 * DIFF_HD,
             N_DIFF_HEADS * 2 * DIFF_HD,
             DIFF_WIDTH]
IN_WIDTH = sum(IN_SPLITS)

kernel_name = "hymba_retnet_diffattn_swiglu"


def rms_norm(x, g):
    xf = x.astype(jnp.float32)
    y = xf * lax.rsqrt(jnp.mean(xf * xf, axis=-1, keepdims=True) + NORM_EPS)
    return (y * g.astype(jnp.float32)).astype(x.dtype)


def rotary(x, pos):
    d = x.shape[-1]
    freqs = 1.0 / (ROPE_BASE ** (jnp.arange(0, d, 2, dtype=jnp.float32) / d))
    ang = pos.astype(jnp.float32)[:, None] * freqs[None, :]
    cos, sin = jnp.cos(ang), jnp.sin(ang)
    xf = x.astype(jnp.float32)
    x1, x2 = xf[..., : d // 2], xf[..., d // 2:]
    return jnp.concatenate([x1 * cos - x2 * sin, x1 * sin + x2 * cos], axis=-1)


def retention_chunkwise(q, k, v, log_g):
    B, H, S, dk = q.shape
    dv = v.shape[-1]
    n = S // RET_CHUNK

    def to_chunks(t):
        return t.reshape(B, H, n, RET_CHUNK, t.shape[-1]).transpose(2, 0, 1, 3, 4)

    idx = jnp.arange(RET_CHUNK, dtype=jnp.float32)
    rel = idx[:, None] - idx[None, :]
    decay_in = jnp.where(rel[None] >= 0,
                         jnp.exp(log_g[:, None, None] * jnp.maximum(rel, 0.0)[None]), 0.0)
    q_dec = jnp.exp(log_g[:, None] * (idx[None, :] + 1.0))
    k_dec = jnp.exp(log_g[:, None] * (RET_CHUNK - 1.0 - idx[None, :]))
    chunk_dec = jnp.exp(log_g * RET_CHUNK)

    def step(state, inp):
        qc, kc, vc = inp
        inner = jnp.einsum('bhid,bhjd->bhij', qc, kc) * decay_in[None]
        o = (jnp.einsum('bhij,bhje->bhie', inner, vc)
             + jnp.einsum('bhid,bhde->bhie', qc * q_dec[None, :, :, None], state))
        new_state = (state * chunk_dec[None, :, None, None]
                     + jnp.einsum('bhjd,bhje->bhde', kc * k_dec[None, :, :, None], vc))
        return new_state, o

    state0 = jnp.zeros((B, H, dk, dv), jnp.float32)
    _, o = lax.scan(step, state0, (to_chunks(q), to_chunks(k), to_chunks(v)))
    return o.transpose(1, 2, 0, 3, 4).reshape(B, H, S, dv)


def diff_attention(q, k, v, lam):
    S = q.shape[3]
    nb = S // Q_BLOCK
    scale = 1.0 / math.sqrt(q.shape[-1])
    kpos = jnp.arange(S)
    kf = k.astype(jnp.float32)
    vf = v.astype(jnp.float32)

    def block(i):
        qb = lax.dynamic_slice_in_dim(q, i * Q_BLOCK, Q_BLOCK, axis=3).astype(jnp.float32)
        s = jnp.einsum('bhmqd,bhmkd->bhmqk', qb, kf) * scale
        qpos = i * Q_BLOCK + jnp.arange(Q_BLOCK)
        mask = kpos[None, :] <= qpos[:, None]
        s = jnp.where(mask[None, None, None], s, -1e30)
        p = jax.nn.softmax(s, axis=-1)
        a = p[:, :, 0] - lam * p[:, :, 1]
        return jnp.einsum('bhqk,bhkd->bhqd', a, vf)

    o = lax.map(block, jnp.arange(nb))
    B, H = q.shape[0], q.shape[1]
    return o.transpose(1, 2, 0, 3, 4).reshape(B, H, S, v.shape[-1])


def setup_inputs(seed: int = 0) -> dict:
    key = jax.random.key(seed)
    ks = jax.random.split(key, 16)
    f32 = jnp.float32
    nrm = lambda k, shape, s: jax.random.normal(k, shape, f32) * s
    gain = lambda k, shape: 1.0 + 0.02 * jax.random.normal(k, shape, f32)
    return {
        "x": jax.random.normal(ks[0], (BATCH, SEQ, D_MODEL), f32),
        "norm1_g": gain(ks[1], (DEPTH, D_MODEL)),
        "w_in": nrm(ks[2], (DEPTH, D_MODEL, IN_WIDTH), D_MODEL ** -0.5),
        "ret_norm_g": gain(ks[3], (DEPTH, N_RET_HEADS, RET_HD)),
        "diff_q_norm_g": gain(ks[4], (DEPTH, DIFF_HD)),
        "diff_k_norm_g": gain(ks[5], (DEPTH, DIFF_HD)),
        "lambda_q1": nrm(ks[6], (DEPTH, DIFF_HD), LAMBDA_STD),
        "lambda_k1": nrm(ks[7], (DEPTH, DIFF_HD), LAMBDA_STD),
        "lambda_q2": nrm(ks[8], (DEPTH, DIFF_HD), LAMBDA_STD),
        "lambda_k2": nrm(ks[9], (DEPTH, DIFF_HD), LAMBDA_STD),
        "diff_subln_g": gain(ks[10], (DEPTH, DIFF_VD)),
        "w_out": nrm(ks[11], (DEPTH, MIX_WIDTH, D_MODEL), MIX_WIDTH ** -0.5),
        "norm2_g": gain(ks[12], (DEPTH, D_MODEL)),
        "w_gate": nrm(ks[13], (DEPTH, D_MODEL, D_FF), D_MODEL ** -0.5),
        "w_up": nrm(ks[14], (DEPTH, D_MODEL, D_FF), D_MODEL ** -0.5),
        "w_down": nrm(ks[15], (DEPTH, D_FF, D_MODEL), D_FF ** -0.5),
    }


def reference(x, norm1_g, w_in, ret_norm_g, diff_q_norm_g, diff_k_norm_g,
              lambda_q1, lambda_k1, lambda_q2, lambda_k2, diff_subln_g,
              w_out, norm2_g, w_gate, w_up, w_down):
    B, S, _ = x.shape
    pos = jnp.arange(S)
    log_g = jnp.log(1.0 - 2.0 ** (-5.0 - jnp.arange(N_RET_HEADS, dtype=jnp.float32)))
    split_pts = list(np.cumsum(IN_SPLITS)[:-1])

    for l in range(DEPTH):
        h = rms_norm(x, norm1_g[l])
        proj = jnp.einsum('bsd,de->bse', h, w_in[l])
        rq, rk, rv, rg, dq, dk, dvv = jnp.split(proj, split_pts, axis=-1)

        heads = lambda t, H, d: t.reshape(B, S, H, d).transpose(0, 2, 1, 3)
        q_r = rotary(heads(rq, N_RET_HEADS, RET_HD), pos)
        k_r = rotary(heads(rk, N_RET_HEADS, RET_HD), pos) * (RET_HD ** -0.5)
        v_r = heads(rv, N_RET_HEADS, RET_HD).astype(jnp.float32)
        ret = retention_chunkwise(q_r, k_r, v_r, log_g)
        ret = ret.transpose(0, 2, 1, 3).astype(x.dtype)
        ret = rms_norm(ret, ret_norm_g[l]).reshape(B, S, RET_WIDTH)
        ret = ret * jax.nn.silu(rg)

        q_d = rms_norm(dq.reshape(B, S, N_DIFF_HEADS, 2, DIFF_HD), diff_q_norm_g[l])
        k_d = rms_norm(dk.reshape(B, S, N_DIFF_HEADS, 2, DIFF_HD), diff_k_norm_g[l])
        q_d = q_d.transpose(0, 2, 3, 1, 4)
        k_d = k_d.transpose(0, 2, 3, 1, 4)
        v_d = heads(dvv, N_DIFF_HEADS, DIFF_VD)
        lam = (jnp.exp(jnp.sum(lambda_q1[l].astype(jnp.float32) * lambda_k1[l].astype(jnp.float32)))
               - jnp.exp(jnp.sum(lambda_q2[l].astype(jnp.float32) * lambda_k2[l].astype(jnp.float32)))
               + LAMBDA_INIT)
        dif = diff_attention(q_d, k_d, v_d, lam)
        dif = dif.transpose(0, 2, 1, 3).astype(x.dtype)
        dif = (rms_norm(dif, diff_subln_g[l]) * (1.0 - LAMBDA_INIT)).reshape(B, S, DIFF_WIDTH)

        mix = jnp.concatenate([ret, dif.astype(ret.dtype)], axis=-1)
        x = x + jnp.einsum('bse,ed->bsd', mix, w_out[l]).astype(x.dtype)

        h2 = rms_norm(x, norm2_g[l])
        ff = jax.nn.silu(jnp.einsum('bsd,df->bsf', h2, w_gate[l])) * jnp.einsum('bsd,df->bsf', h2, w_up[l])
        x = x + jnp.einsum('bsf,fd->bsd', ff, w_down[l]).astype(x.dtype)
    return x
```

```cpp
#include <hip/hip_runtime.h>
#include <cstdint>
#include <cstdio>

namespace nv {
constexpr int M = 16384, D = 1024, NIN = 3584, FF = 2816, SEQ = 8192;
constexpr int RQ = 0, RK = 512, RV = 1024, RG = 1536, DQ = 2048, DK = 2560, DV = 3072;
constexpr float EPS = 1e-6f, C2 = 0.125f * 1.4426950408889634f, LAM_INIT = 0.2f;
typedef unsigned short bf16_t;
constexpr size_t MiB = 1u << 20;
constexpr size_t WS_RSTD1 = 30 * MiB, WS_RSTD2N = 30 * MiB + 512 * 1024, WS_SS2 = 31 * MiB, WS_XN = 32 * MiB, WS_P = 64 * MiB, WS_H = 64 * MiB, WS_O = 176 * MiB, WS_MIX = 208 * MiB;

__device__ __forceinline__ float bf2f(bf16_t v) { return __uint_as_float((unsigned)v << 16); }
__device__ __forceinline__ bf16_t f2bf(float f) { unsigned u = __float_as_uint(f); return (bf16_t)((u + 0x7fffu + ((u >> 16) & 1u)) >> 16); }
__device__ __forceinline__ float wave_sum(float v) {
#pragma unroll
    for (int o = 1; o < 64; o <<= 1) v += __shfl_xor(v, o);
    return v;
}
__device__ __forceinline__ void rope_cs(int pos, int i, float& c, float& s) {
    const float freq = __builtin_amdgcn_exp2f(-(float)i * (13.287712379549449f / 32.0f));
    const double rev = (double)pos * (double)freq * 0.15915494309189535;
    const float fr = (float)(rev - __builtin_floor(rev));
    c = __builtin_amdgcn_cosf(fr); s = __builtin_amdgcn_sinf(fr);
}
__device__ __forceinline__ float silu(float g) { return g / (1.f + __expf(-g)); }

__global__ void __launch_bounds__(256) n_rowstat(const float* __restrict__ x, float* __restrict__ rstd, bf16_t* xn, float* ss) {
    const int w = (blockIdx.x * 256 + threadIdx.x) >> 6, lane = threadIdx.x & 63;
    if (w >= M) return;
    const float* xr = x + (size_t)w * D; float s = 0.f;
    for (int j = lane; j < D; j += 64) { const float v = xr[j]; s += v * v; if (xn) xn[(size_t)w * D + j] = f2bf(v); }
    s = wave_sum(s);
    if (lane == 0) rstd[w] = rsqrtf(s * (1.f / D) + EPS);
    if (ss && lane < 16) ss[(size_t)w * 16 + lane] = s * (1.f / 16.f);
}

struct AfX { const float* x; const float* rstd; const float* g; __device__ __forceinline__ float operator()(int m, int k) const { return x[(size_t)m * D + k] * rstd[m] * g[k]; } };
struct AfB { const bf16_t* a; int lda; __device__ __forceinline__ float operator()(int m, int k) const { return bf2f(a[(size_t)m * lda + k]); } };

template <int DUAL, class AF, class EP>
__global__ void __launch_bounds__(256) ngemm(AF af, const float* __restrict__ W, const float* __restrict__ W2, int N, int K, EP ep) {
    __shared__ float As[16][68]; __shared__ float Bs[16][64]; __shared__ float Bs2[DUAL ? 16 : 1][64]; __shared__ float Cs[DUAL ? 2 : 1][64][65];
    const int tid = threadIdx.x, tx = tid & 15, ty = tid >> 4, m0 = blockIdx.y * 64, n0 = blockIdx.x * 64;
    float acc[4][4], acc2[4][4];
#pragma unroll
    for (int i = 0; i < 4; ++i)
#pragma unroll
        for (int j = 0; j < 4; ++j) { acc[i][j] = 0.f; acc2[i][j] = 0.f; }
    for (int k0 = 0; k0 < K; k0 += 16) {
#pragma unroll
        for (int i = 0; i < 4; ++i) { const int idx = tid + i * 256; { const int r = idx >> 4, c = idx & 15; As[c][r] = af(m0 + r, k0 + c); }
            { const int r = idx >> 6, c = idx & 63; Bs[r][c] = W[(size_t)(k0 + r) * N + n0 + c]; if (DUAL) Bs2[r][c] = W2[(size_t)(k0 + r) * N + n0 + c]; } }
        __syncthreads();
#pragma unroll
        for (int kk = 0; kk < 16; ++kk) {
            float a[4], b[4], b2[4];
#pragma unroll
            for (int i = 0; i < 4; ++i) { a[i] = As[kk][ty * 4 + i]; b[i] = Bs[kk][tx * 4 + i]; b2[i] = DUAL ? Bs2[kk][tx * 4 + i] : 0.f; }
#pragma unroll
            for (int i = 0; i < 4; ++i)
#pragma unroll
                for (int j = 0; j < 4; ++j) { acc[i][j] += a[i] * b[j]; if (DUAL) acc2[i][j] += a[i] * b2[j]; }
        }
        __syncthreads();
    }
#pragma unroll
    for (int i = 0; i < 4; ++i)
#pragma unroll
        for (int j = 0; j < 4; ++j) { Cs[0][ty * 4 + i][tx * 4 + j] = acc[i][j]; if (DUAL) Cs[DUAL ? 1 : 0][ty * 4 + i][tx * 4 + j] = acc2[i][j]; }
    __syncthreads();
    ep(Cs, m0, n0, tid);
}

struct EpIn {
    bf16_t* P; const float* gq; const float* gk;
    __device__ __forceinline__ void operator()(float (*Cs)[64][65], int m0, int n0, int tid) const {
        const int r = tid >> 2, c = tid & 3, row = m0 + r, sec = n0 / 512, pos = row & (SEQ - 1);
        float lo[8], hi[8];
#pragma unroll
        for (int i = 0; i < 8; ++i) { lo[i] = Cs[0][r][8 * c + i]; hi[i] = Cs[0][r][32 + 8 * c + i]; }
        if (sec == 0 || sec == 1) {
            const float sc = sec == 1 ? 0.125f : 1.f;
#pragma unroll
            for (int i = 0; i < 8; ++i) { float cs, sn; rope_cs(pos, 8 * c + i, cs, sn); const float a = lo[i], b = hi[i]; lo[i] = (a * cs - b * sn) * sc; hi[i] = (a * sn + b * cs) * sc; }
        } else if (sec == 4 || sec == 5) {
            float ss = 0.f;
#pragma unroll
            for (int i = 0; i < 8; ++i) ss += lo[i] * lo[i] + hi[i] * hi[i];
            ss += __shfl_xor(ss, 1); ss += __shfl_xor(ss, 2);
            const float rs = rsqrtf(ss * (1.f / 64.f) + EPS) * (sec == 4 ? C2 : 1.f); const float* g = sec == 4 ? gq : gk;
#pragma unroll
            for (int i = 0; i < 8; ++i) { lo[i] *= rs * g[8 * c + i]; hi[i] *= rs * g[32 + 8 * c + i]; }
        }
        bf16_t* o = P + (size_t)row * NIN + n0;
#pragma unroll
        for (int i = 0; i < 8; ++i) { o[8 * c + i] = f2bf(lo[i]); o[32 + 8 * c + i] = f2bf(hi[i]); }
    }
};
struct EpOut {
    const float* x; float* out;
    __device__ __forceinline__ void operator()(float (*Cs)[64][65], int m0, int n0, int tid) const {
        const int r = tid >> 2, c = tid & 3; const size_t off = (size_t)(m0 + r) * D + n0 + 16 * c;
#pragma unroll
        for (int i = 0; i < 16; ++i) out[off + i] = x[off + i] + Cs[0][r][16 * c + i];
    }
};
struct EpGU {
    bf16_t* H;
    __device__ __forceinline__ void operator()(float (*Cs)[64][65], int m0, int n0, int tid) const {
        const int r = tid >> 2, c = tid & 3; const size_t off = (size_t)(m0 + r) * FF + n0 + 16 * c;
#pragma unroll
        for (int i = 0; i < 16; ++i) H[off + i] = f2bf(silu(Cs[0][r][16 * c + i]) * Cs[1][r][16 * c + i]);
    }
};

__global__ void __launch_bounds__(256) n_attn(const bf16_t* __restrict__ P, bf16_t* __restrict__ O) {
    __shared__ float Ks[64][64]; __shared__ float Vs[64][64];
    const int tid = threadIdx.x, qb = blockIdx.x, bph = blockIdx.y, b = bph >> 4, ph = bph & 15;
    const int qcol = DQ + (ph >> 1) * 64, kcol = DK + (ph >> 1) * 64, vcol = DV + (ph >> 2) * 128 + (ph & 1) * 64;
    const int qi = tid & 63, ec = tid >> 6; const size_t row = (size_t)b * SEQ + qb * 64 + qi;
    float q[64], o[16], m = -INFINITY, l = 0.f;
#pragma unroll
    for (int d = 0; d < 64; ++d) q[d] = bf2f(P[row * NIN + qcol + d]);
#pragma unroll
    for (int i = 0; i < 16; ++i) o[i] = 0.f;
    for (int kt = 0; kt <= qb; ++kt) {
#pragma unroll
        for (int i = 0; i < 16; ++i) { const int idx = tid + i * 256, j = idx >> 6, d = idx & 63; const size_t kr = ((size_t)b * SEQ + kt * 64 + j) * NIN;
            Ks[j][d] = bf2f(P[kr + kcol + d]); Vs[j][d] = bf2f(P[kr + vcol + d]); }
        __syncthreads();
        const int jmax = (kt == qb) ? qi : 63;
        for (int j = 0; j < 64; ++j) {
            if (j <= jmax) {
                float s = 0.f;
#pragma unroll
                for (int d = 0; d < 64; ++d) s += q[d] * Ks[j][d];
                const float mn = fmaxf(m, s), corr = __builtin_amdgcn_exp2f(m - mn), p = __builtin_amdgcn_exp2f(s - mn);
                l = l * corr + p;
#pragma unroll
                for (int i = 0; i < 16; ++i) o[i] = o[i] * corr + p * Vs[j][16 * ec + i];
                m = mn;
            }
        }
        __syncthreads();
    }
    const float rl = 1.f / l;
#pragma unroll
    for (int i = 0; i < 16; ++i) O[row * 1024 + ph * 64 + 16 * ec + i] = f2bf(o[i] * rl);
}

__global__ void __launch_bounds__(64) n_ret(const bf16_t* __restrict__ P, const float* __restrict__ retg, bf16_t* __restrict__ mix) {
    __shared__ float qs[32][64], ks[32][64], vs[32][64], gs[32][64];
    const int bh = blockIdx.x, b = bh >> 3, h = bh & 7, e = threadIdx.x;
    const float gamma = 1.f - __builtin_amdgcn_exp2f(-5.f - (float)h), ge = retg[h * 64 + e];
    float st[64];
#pragma unroll
    for (int d = 0; d < 64; ++d) st[d] = 0.f;
    for (int t0 = 0; t0 < SEQ; t0 += 32) {
        for (int i = 0; i < 32; ++i) { const size_t pr = ((size_t)b * SEQ + t0 + i) * NIN + h * 64 + e;
            qs[i][e] = bf2f(P[pr + RQ]); ks[i][e] = bf2f(P[pr + RK]); vs[i][e] = bf2f(P[pr + RV]); gs[i][e] = bf2f(P[pr + RG]); }
        __syncthreads();
        for (int i = 0; i < 32; ++i) {
            const float v = vs[i][e]; float acc = 0.f;
#pragma unroll
            for (int d = 0; d < 64; ++d) { st[d] = gamma * st[d] + ks[i][d] * v; acc += qs[i][d] * st[d]; }
            const float ss = wave_sum(acc * acc);
            const float y = acc * rsqrtf(ss * (1.f / 64.f) + EPS) * ge * silu(gs[i][e]);
            mix[((size_t)b * SEQ + t0 + i) * 1024 + h * 64 + e] = f2bf(y);
        }
        __syncthreads();
    }
}

__device__ __forceinline__ float lambda_full(const float* q1, const float* k1, const float* q2, const float* k2) {
    float a = 0.f, b = 0.f;
    for (int i = 0; i < 64; ++i) { a += q1[i] * k1[i]; b += q2[i] * k2[i]; }
    return __expf(a) - __expf(b) + LAM_INIT;
}
__global__ void __launch_bounds__(256) n_difmix(const bf16_t* __restrict__ O, const float* q1, const float* k1, const float* q2, const float* k2, const float* __restrict__ gsub, bf16_t* __restrict__ mix) {
    const int idx = blockIdx.x * 256 + threadIdx.x; if (idx >= M * 4) return;
    const int row = idx >> 2, h = idx & 3; const float lam = lambda_full(q1, k1, q2, k2);
    const bf16_t* o1 = O + (size_t)row * 1024 + h * 256; const bf16_t* o2 = o1 + 128; float ss = 0.f;
    for (int e = 0; e < 128; ++e) { const float d = bf2f(o1[e]) - lam * bf2f(o2[e]); ss += d * d; }
    const float rs = rsqrtf(ss * (1.f / 128.f) + EPS) * (1.f - LAM_INIT);
    for (int e = 0; e < 128; ++e) { const float d = bf2f(o1[e]) - lam * bf2f(o2[e]); mix[(size_t)row * 1024 + 512 + h * 128 + e] = f2bf(d * rs * gsub[e]); }
}
}

extern "C" void kernel_launch(void* const* d_in, const int* in_sizes, int n_in, void* d_out, int out_size, void* d_ws, size_t ws_size, hipStream_t stream) {
    using namespace nv;
    const float* x = (const float*)d_in[0]; const float* g1 = (const float*)d_in[1]; const float* w_in = (const float*)d_in[2]; const float* retg = (const float*)d_in[3];
    const float* gq = (const float*)d_in[4]; const float* gk = (const float*)d_in[5]; const float* lq1 = (const float*)d_in[6]; const float* lk1 = (const float*)d_in[7];
    const float* lq2 = (const float*)d_in[8]; const float* lk2 = (const float*)d_in[9]; const float* gsub = (const float*)d_in[10]; const float* w_out = (const float*)d_in[11];
    const float* g2 = (const float*)d_in[12]; const float* w_gate = (const float*)d_in[13]; const float* w_up = (const float*)d_in[14]; const float* w_down = (const float*)d_in[15];
    float* out = (float*)d_out; unsigned char* ws = (unsigned char*)d_ws;
    float* rstd1 = (float*)(ws + WS_RSTD1); float* rstd2 = (float*)(ws + WS_RSTD2N); float* ss2 = (float*)(ws + WS_SS2);
    bf16_t* XN = (bf16_t*)(ws + WS_XN); bf16_t* P = (bf16_t*)(ws + WS_P); bf16_t* H = (bf16_t*)(ws + WS_H); bf16_t* O = (bf16_t*)(ws + WS_O); bf16_t* MIX = (bf16_t*)(ws + WS_MIX);
    n_rowstat<<<M / 4, 256, 0, stream>>>(x, rstd1, nullptr, nullptr);
    ngemm<0, AfX, EpIn><<<dim3(NIN / 64, M / 64), 256, 0, stream>>>(AfX{x, rstd1, g1}, w_in, nullptr, NIN, D, EpIn{P, gq, gk});
    n_attn<<<dim3(SEQ / 64, 32), 256, 0, stream>>>(P, O);
    n_ret<<<16, 64, 0, stream>>>(P, retg, MIX);
    n_difmix<<<M * 4 / 256, 256, 0, stream>>>(O, lq1, lk1, lq2, lk2, gsub, MIX);
    ngemm<0, AfB, EpOut><<<dim3(D / 64, M / 64), 256, 0, stream>>>(AfB{MIX, 1024}, w_out, nullptr, D, 1024, EpOut{x, out});
    n_rowstat<<<M / 4, 256, 0, stream>>>(out, rstd2, XN, ss2);
    ngemm<1, AfX, EpGU><<<dim3(FF / 64, M / 64), 256, 0, stream>>>(AfX{out, rstd2, g2}, w_gate, w_up, FF, D, EpGU{H});
    ngemm<0, AfB, EpOut><<<dim3(D / 64, M / 64), 256, 0, stream>>>(AfB{H, FF}, w_down, nullptr, D, FF, EpOut{out, out});
}
```

```cpp
#include <hip/hip_runtime.h>
#include <cstdio>
#include <cstdint>

namespace pg8 {
#define PG8_LAS __attribute__((address_space(3)))
typedef unsigned short bf16_t;
typedef short bf16x8 __attribute__((ext_vector_type(8)));
typedef float f32x4 __attribute__((ext_vector_type(4)));
typedef unsigned u32x4 __attribute__((ext_vector_type(4)));
constexpr int BM = 256, BK = 64, HALF = 128, HTB = HALF * BK * 2  , STAGE_BYTES = 8 * HTB, NXCD = 8, WGM = 8;

__host__ __device__ __forceinline__ int lds_byte(int r, int c) { const int st = (r >> 4) * 2 + (c >> 5), rr = r & 15, cc = c & 31, ob = rr * 64 + cc * 2; return st * 1024 + (ob ^ (((ob >> 9) & 1) << 5)); }
__host__ __device__ __forceinline__ void stage_rc(int b, int& R, int& C) { const int st = b / 1024, sb = b % 1024, swz = sb ^ (((sb >> 9) & 1) << 5); R = (st >> 1) * 16 + swz / 64; C = (st & 1) * 32 + (swz % 64) / 2; }
__host__ __device__ __forceinline__ int perm32(int rho) { const int n = rho >> 4, i = rho & 15; return 8 * (i >> 2) + 4 * n + (i & 3); }

struct Unit { int pm, pn; };
struct Gemm { const bf16_t* A; const bf16_t* Bt; int M, N, K; };

struct StaticOrder {
    int nM, nN, nwg, G, c;
    __host__ __device__ void init(int M, int N, int G_, int c_) { nM = M / BM; nN = N / BM; nwg = nM * nN; G = G_; c = c_; }
    __host__ __device__ bool next(int i, Unit& u) const {
        const long L = (long)i * G + c; if (L >= nwg) return false;
        int wgid = (int)L; { const int q = nwg / NXCD, r = nwg % NXCD, xcd = wgid % NXCD, off = wgid / NXCD; wgid = (xcd < r ? xcd * (q + 1) : r * (q + 1) + (xcd - r) * q) + off; }
        const int nig = WGM * nN, gid = wgid / nig, fm = gid * WGM, gsz = (nM - fm) < WGM ? (nM - fm) : WGM;
        u.pm = fm + ((wgid % nig) % gsz); u.pn = (wgid % nig) / gsz; return true;
    }
    __device__ __forceinline__ void a_ready(const Unit&) const {}
    __device__ __forceinline__ void done(const Unit&) const {}
};

__device__ __forceinline__ unsigned cvt_pk_bf16(float lo, float hi) { unsigned r; asm volatile("v_cvt_pk_bf16_f32 %0, %1, %2" : "=v"(r) : "v"(lo), "v"(hi)); return r; }
typedef float f32x2 __attribute__((ext_vector_type(2)));
__device__ __forceinline__ float sum_rows4(float v) {
    const auto a = __builtin_amdgcn_permlane16_swap(__float_as_uint(v), __float_as_uint(v), false, false); v = __uint_as_float(a[0]) + __uint_as_float(a[1]);
    const auto b = __builtin_amdgcn_permlane32_swap(__float_as_uint(v), __float_as_uint(v), false, false); return __uint_as_float(b[0]) + __uint_as_float(b[1]);
}
constexpr float EPS_N = 1e-6f, QC2 = 0.125f * 1.4426950408889634f;
struct EpiIn {
    static constexpr bool PERM = true, AFTER_DRAIN = false;
    bf16_t* P; const float* rstd1; const float* ropec; const float* ropes; const float* gq; const float* gk; const PG8_LAS float* rs1; int row0;
    __device__ __forceinline__ void operator()(const f32x4 (&acc)[2][2][4][2], const Unit& u, int wr, int wc, int fr, int fq) const {
        const int pn = u.pn;
        const int kind = (pn < 4) ? 1 : ((pn >= 8 && pn < 12) ? 2 : 0);
        const float sc = (kind == 1) ? ((pn >= 2) ? 0.125f : 1.f) : ((kind == 2 && pn < 10) ? QC2 : 1.f);
        const int colb = pn * BM + 64 * wc + 8 * fq;
        f32x4 g[2][2];
#pragma unroll
        for (int bj = 0; bj < 2; ++bj)
#pragma unroll
            for (int n = 0; n < 2; ++n) g[bj][n] = (kind == 2) ? *(const f32x4*)(((pn < 10) ? gq : gk) + 32 * bj + 8 * fq + 4 * n) : (f32x4){1.f, 1.f, 1.f, 1.f};
#pragma unroll
        for (int ai = 0; ai < 2; ++ai)
#pragma unroll
            for (int m = 0; m < 4; ++m) {
                const int row = u.pm * BM + ai * HALF + wr * 64 + m * 16 + fr;
                const float rs = ((unsigned)(row - row0) < 2048u) ? rs1[row - row0] : rstd1[row];
                f32x4 v[2][2];
#pragma unroll
                for (int bj = 0; bj < 2; ++bj)
#pragma unroll
                    for (int n = 0; n < 2; ++n) v[bj][n] = acc[ai][bj][m][n] * rs;
                if (kind == 1) {
                    const int pos = row & 8191;
#pragma unroll
                    for (int n = 0; n < 2; ++n) { const f32x4 c4 = *(const f32x4*)(ropec + pos * 32 + 8 * fq + 4 * n), s4 = *(const f32x4*)(ropes + pos * 32 + 8 * fq + 4 * n);
                        const f32x4 a = v[0][n], b = v[1][n]; v[0][n] = (a * c4 - b * s4) * sc; v[1][n] = (a * s4 + b * c4) * sc; }
                } else if (kind == 2) {
                    float ss = 0.f;
#pragma unroll
                    for (int bj = 0; bj < 2; ++bj)
#pragma unroll
                        for (int n = 0; n < 2; ++n) { const f32x4 t = v[bj][n]; ss += (t[0] * t[0] + t[1] * t[1]) + (t[2] * t[2] + t[3] * t[3]); }
                    ss = sum_rows4(ss);
                    const float r = rsqrtf(ss * (1.f / 64.f) + EPS_N) * sc;
#pragma unroll
                    for (int bj = 0; bj < 2; ++bj)
#pragma unroll
                        for (int n = 0; n < 2; ++n) v[bj][n] = v[bj][n] * r * g[bj][n];
                }
                bf16_t* rowp = P + (size_t)row * 3584 + colb;
#pragma unroll
                for (int bj = 0; bj < 2; ++bj) { u32x4 w; w.x = cvt_pk_bf16(v[bj][0][0], v[bj][0][1]); w.y = cvt_pk_bf16(v[bj][0][2], v[bj][0][3]); w.z = cvt_pk_bf16(v[bj][1][0], v[bj][1][1]); w.w = cvt_pk_bf16(v[bj][1][2], v[bj][1][3]);
                    *(u32x4*)(rowp + 32 * bj) = w; }
            }
    }
};
struct EpiOut {
    static constexpr bool PERM = true, AFTER_DRAIN = false;
    const float* x; bf16_t* xn; float* ss2;
    __device__ __forceinline__ void operator()(const f32x4 (&acc)[2][2][4][2], const Unit& u, int wr, int wc, int fr, int fq) const {
        const int colb = u.pn * BM + 32 * wc + 8 * fq;
#pragma unroll
        for (int ai = 0; ai < 2; ++ai)
#pragma unroll
            for (int m = 0; m < 4; ++m) {
                const int row = u.pm * BM + ai * HALF + wr * 64 + m * 16 + fr; const size_t off = (size_t)row * 1024 + colb; float ss = 0.f;
#pragma unroll
                for (int bj = 0; bj < 2; ++bj) { const f32x4 v0 = __builtin_nontemporal_load((const f32x4*)(x + off + HALF * bj)) + acc[ai][bj][m][0], v1 = __builtin_nontemporal_load((const f32x4*)(x + off + HALF * bj + 4)) + acc[ai][bj][m][1];
                    ss += (v0[0] * v0[0] + v0[1] * v0[1]) + (v0[2] * v0[2] + v0[3] * v0[3]) + (v1[0] * v1[0] + v1[1] * v1[1]) + (v1[2] * v1[2] + v1[3] * v1[3]);
                    u32x4 w; w.x = cvt_pk_bf16(v0[0], v0[1]); w.y = cvt_pk_bf16(v0[2], v0[3]); w.z = cvt_pk_bf16(v1[0], v1[1]); w.w = cvt_pk_bf16(v1[2], v1[3]);
                    *(u32x4*)(xn + off + HALF * bj) = w; }
                ss = sum_rows4(ss);
                if (fq == 0) ss2[(size_t)row * 16 + u.pn * 4 + wc] = ss;
            }
    }
};
struct EpiGU {
    static constexpr bool PERM = true, AFTER_DRAIN = false;
    bf16_t* H; const float* ss2; const PG8_LAS float* rs2; int row0;
    __device__ __forceinline__ void operator()(const f32x4 (&acc)[2][2][4][2], const Unit& u, int wr, int wc, int fr, int fq) const {
        const int colb = u.pn * HALF + 32 * wc + 8 * fq;
#pragma unroll
        for (int ai = 0; ai < 2; ++ai)
#pragma unroll
            for (int m = 0; m < 4; ++m) {
                const int row = u.pm * BM + ai * HALF + wr * 64 + m * 16 + fr;
                float rs;
                if ((unsigned)(u.pm * BM - row0) < 2048u) rs = rs2[row - row0];
                else { const f32x4* sp = (const f32x4*)(ss2 + (size_t)row * 16); const f32x4 sa = sp[0] + sp[1] + sp[2] + sp[3]; rs = rsqrtf(((sa[0] + sa[1]) + (sa[2] + sa[3])) * (1.f / 1024.f) + EPS_N); }
                f32x4 hv[2];
#pragma unroll
                for (int n = 0; n < 2; ++n) { const f32x4 gt = acc[ai][0][m][n] * rs, up = acc[ai][1][m][n] * rs;
#pragma unroll
                    for (int e = 0; e < 4; ++e) hv[n][e] = gt[e] * __builtin_amdgcn_rcpf(1.f + __builtin_amdgcn_exp2f(-1.4426950408889634f * gt[e])) * up[e]; }
                u32x4 w; w.x = cvt_pk_bf16(hv[0][0], hv[0][1]); w.y = cvt_pk_bf16(hv[0][2], hv[0][3]); w.z = cvt_pk_bf16(hv[1][0], hv[1][1]); w.w = cvt_pk_bf16(hv[1][2], hv[1][3]);
                *(u32x4*)(H + (size_t)row * 2816 + colb) = w;
            }
    }
};
struct EpiDown {
    static constexpr bool PERM = true, AFTER_DRAIN = false;
    const bf16_t* xn; float* out;
    __device__ __forceinline__ void operator()(const f32x4 (&acc)[2][2][4][2], const Unit& u, int wr, int wc, int fr, int fq) const {
        const int colb = u.pn * BM + 32 * wc + 8 * fq;
#pragma unroll
        for (int ai = 0; ai < 2; ++ai)
#pragma unroll
            for (int m = 0; m < 4; ++m) {
                const size_t off = (size_t)(u.pm * BM + ai * HALF + wr * 64 + m * 16 + fr) * 1024 + colb;
#pragma unroll
                for (int bj = 0; bj < 2; ++bj) { const u32x4 w = *(const u32x4*)(xn + off + HALF * bj);
                    const f32x4 r0 = {__uint_as_float(w.x << 16), __uint_as_float(w.x & 0xffff0000u), __uint_as_float(w.y << 16), __uint_as_float(w.y & 0xffff0000u)};
                    const f32x4 r1 = {__uint_as_float(w.z << 16), __uint_as_float(w.z & 0xffff0000u), __uint_as_float(w.w << 16), __uint_as_float(w.w & 0xffff0000u)};
                    __builtin_nontemporal_store(r0 + acc[ai][bj][m][0], (f32x4*)(out + off + HALF * bj)); __builtin_nontemporal_store(r1 + acc[ai][bj][m][1], (f32x4*)(out + off + HALF * bj + 4)); }
            }
    }
};
template <class Epi, class Sched, bool ALIGN_EPI = false, bool SP2 = false>
__device__ __forceinline__ void gemm_phase(PG8_LAS unsigned char* lds, const Gemm g, const Sched& S, const Epi& E) {
    const int tid = threadIdx.x, wid = __builtin_amdgcn_readfirstlane(tid >> 6), lane = tid & 63, wr = wid >> 2, wc = wid & 3, fr = lane & 15, fq = lane >> 4;
    const int K = g.K, nt = K / BK;
    unsigned voffA[2], voffB[2];
#pragma unroll
    for (int i = 0; i < 2; ++i) { int R, C; stage_rc(tid * 16 + i * 8192, R, C); const int Rb = Epi::PERM ? ((R & ~31) + perm32(R & 31)) : R;
        voffA[i] = (unsigned)(R * K + C) * 2u; voffB[i] = (unsigned)(Rb * K + C) * 2u; }
    const size_t kstep = (size_t)(BK * 2);
    const size_t hstep = (size_t)HALF * K * 2;
    const size_t tstep = 2 * hstep;
    const unsigned ldsw = (unsigned)wid * 1024u;
    const int aoff = lds_byte(wr * 64 + fr, fq * 8), boff = lds_byte(wc * 32 + fr, fq * 8);
#define PG8_SA(b, h) (((b) * 2 + (h)) * HTB)
#define PG8_SB(b, h) ((4 + (b) * 2 + (h)) * HTB)
#define PG8_STAGE(bufoff, gbase, voff) do { _Pragma("unroll") for (int _i = 0; _i < 2; ++_i) \
        __builtin_amdgcn_global_load_lds((const unsigned*)((const char*)(gbase) + (voff)[_i]), (PG8_LAS unsigned*)(lds + (bufoff) + ldsw + _i * 8192), 16, 0, 0); } while (0)
#define PG8_LDA(dst, b, h) do { _Pragma("unroll") for (int m = 0; m < 4; ++m) _Pragma("unroll") for (int k = 0; k < 2; ++k) dst[m][k] = *(const PG8_LAS bf16x8*)(lds + PG8_SA(b, h) + aoff + m * 2048 + k * 1024); } while (0)
#define PG8_LDB(dst, b, h) do { _Pragma("unroll") for (int n = 0; n < 2; ++n) _Pragma("unroll") for (int k = 0; k < 2; ++k) dst[n][k] = *(const PG8_LAS bf16x8*)(lds + PG8_SB(b, h) + boff + n * 2048 + k * 1024); } while (0)
#define PG8_MMA(ai, bj, At, Bt) do { __builtin_amdgcn_s_setprio(1); _Pragma("unroll") for (int m = 0; m < 4; ++m) _Pragma("unroll") for (int n = 0; n < 2; ++n) _Pragma("unroll") for (int k = 0; k < 2; ++k) \
        acc[ai][bj][m][n] = __builtin_amdgcn_mfma_f32_16x16x32_bf16(Bt[n][k], At[m][k], acc[ai][bj][m][n], 0, 0, 0); __builtin_amdgcn_s_setprio(0); } while (0)
#define PG8_WAIT_V(n) asm volatile("s_waitcnt vmcnt(" #n ")" ::: "memory")
#define PG8_WAIT_L(n) asm volatile("s_waitcnt lgkmcnt(" #n ")" ::: "memory")
#define PG8_BAR __builtin_amdgcn_s_barrier()
#define PG8_SCHED __builtin_amdgcn_sched_barrier(0)
    Unit cur, nxt; int ui = 0;
    if (!S.next(0, cur)) return;
    f32x4 acc[2][2][4][2];
#pragma unroll
    for (int a = 0; a < 2; ++a)
#pragma unroll
        for (int b = 0; b < 2; ++b)
#pragma unroll
            for (int m = 0; m < 4; ++m)
#pragma unroll
                for (int n = 0; n < 2; ++n) acc[a][b][m][n] = (f32x4){0.f, 0.f, 0.f, 0.f};
    bf16x8 At[4][2], B0[2][2], B1[2][2];
    const char* cA = (const char*)g.A + (size_t)cur.pm * tstep; const char* cB = (const char*)g.Bt + (size_t)cur.pn * tstep;
    S.a_ready(cur);
    if constexpr (SP2) {
        PG8_STAGE(PG8_SB(0, 0), cB, voffB); PG8_STAGE(PG8_SB(0, 1), cB + hstep, voffB); PG8_STAGE(PG8_SA(0, 0), cA, voffA); PG8_STAGE(PG8_SA(0, 1), cA + hstep, voffA);
        if (wr == 1) PG8_BAR;
        PG8_WAIT_V(2); PG8_BAR;
        PG8_STAGE(PG8_SB(1, 0), cB + kstep, voffB); PG8_STAGE(PG8_SA(1, 0), cA + kstep, voffA); PG8_STAGE(PG8_SB(1, 1), cB + hstep + kstep, voffB);
        PG8_WAIT_V(6); PG8_BAR;
    } else {
        PG8_STAGE(PG8_SB(0, 0), cB, voffB); PG8_STAGE(PG8_SA(0, 0), cA, voffA); PG8_STAGE(PG8_SB(0, 1), cB + hstep, voffB); PG8_STAGE(PG8_SA(0, 1), cA + hstep, voffA);
        if (wr == 1) PG8_BAR;
        PG8_WAIT_V(4); PG8_BAR;
        PG8_STAGE(PG8_SB(1, 0), cB + kstep, voffB); PG8_STAGE(PG8_SA(1, 0), cA + kstep, voffA); PG8_STAGE(PG8_SB(1, 1), cB + hstep + kstep, voffB);
        PG8_WAIT_V(6); PG8_BAR;
    }
    for (;;) {
        const bool has_next = S.next(ui + 1, nxt);
        const char* nA = has_next ? (const char*)g.A + (size_t)nxt.pm * tstep : cA; const char* nB = has_next ? (const char*)g.Bt + (size_t)nxt.pn * tstep : cB;
        for (int t = 0; t < nt; t += 2) {
            const bool last = (t == nt - 2);
            const char* a1 = cA + (size_t)(t + 1) * kstep;
            const char* a2 = last ? nA : cA + (size_t)(t + 2) * kstep; const char* b2 = last ? nB : cB + (size_t)(t + 2) * kstep;
            const char* a3 = a2 + kstep; const char* b3 = b2 + kstep;
            if (last && has_next) S.a_ready(nxt);
            if constexpr (SP2) {
            PG8_LDB(B0, 0, 0); PG8_LDB(B1, 0, 1); PG8_SCHED; PG8_LDA(At, 0, 0); PG8_STAGE(PG8_SA(1, 1), a1 + hstep, voffA);
            PG8_WAIT_V(8); PG8_WAIT_L(0); PG8_BAR; PG8_MMA(0, 0, At, B0); PG8_MMA(0, 1, At, B1); PG8_BAR; PG8_SCHED;
            PG8_LDA(At, 0, 1); PG8_STAGE(PG8_SB(0, 0), b2, voffB); PG8_STAGE(PG8_SB(0, 1), b2 + hstep, voffB); PG8_STAGE(PG8_SA(0, 0), a2, voffA);
            PG8_WAIT_V(8); PG8_WAIT_L(0); PG8_BAR; PG8_MMA(1, 0, At, B0); PG8_MMA(1, 1, At, B1); PG8_BAR; PG8_SCHED;
            PG8_LDB(B0, 1, 0); PG8_LDB(B1, 1, 1); PG8_SCHED; PG8_LDA(At, 1, 0); PG8_STAGE(PG8_SA(0, 1), a2 + hstep, voffA);
            PG8_WAIT_V(8); PG8_WAIT_L(0); PG8_BAR; PG8_MMA(0, 0, At, B0); PG8_MMA(0, 1, At, B1); PG8_BAR; PG8_SCHED;
            PG8_LDA(At, 1, 1); PG8_STAGE(PG8_SB(1, 0), b3, voffB); PG8_STAGE(PG8_SB(1, 1), b3 + hstep, voffB); PG8_STAGE(PG8_SA(1, 0), a3, voffA);
            PG8_WAIT_V(8); PG8_WAIT_L(0); PG8_BAR; PG8_MMA(1, 0, At, B0); PG8_MMA(1, 1, At, B1); PG8_BAR; PG8_SCHED;
            } else {
            PG8_LDB(B0, 0, 0); PG8_SCHED; PG8_LDA(At, 0, 0); PG8_STAGE(PG8_SA(1, 1), a1 + hstep, voffA);
            PG8_WAIT_L(8); PG8_BAR; PG8_WAIT_L(0); PG8_MMA(0, 0, At, B0); PG8_BAR; PG8_SCHED;
            PG8_LDB(B1, 0, 1); PG8_STAGE(PG8_SB(0, 0), b2, voffB);
            PG8_BAR; PG8_WAIT_L(0); PG8_MMA(0, 1, At, B1); PG8_BAR;
            PG8_LDA(At, 0, 1); PG8_STAGE(PG8_SA(0, 0), a2, voffA);
            PG8_BAR; PG8_WAIT_L(0); PG8_MMA(1, 0, At, B0); PG8_BAR; PG8_SCHED;
            PG8_STAGE(PG8_SB(0, 1), b2 + hstep, voffB);
            PG8_WAIT_V(6); PG8_BAR; PG8_MMA(1, 1, At, B1); PG8_BAR;
            PG8_LDB(B0, 1, 0); PG8_SCHED; PG8_LDA(At, 1, 0); PG8_STAGE(PG8_SA(0, 1), a2 + hstep, voffA);
            PG8_WAIT_L(8); PG8_BAR; PG8_WAIT_L(0); PG8_MMA(0, 0, At, B0); PG8_BAR; PG8_SCHED;
            PG8_LDB(B1, 1, 1); PG8_STAGE(PG8_SB(1, 0), b3, voffB);
            PG8_BAR; PG8_WAIT_L(0); PG8_MMA(0, 1, At, B1); PG8_BAR;
            PG8_LDA(At, 1, 1); PG8_STAGE(PG8_SA(1, 0), a3, voffA);
            PG8_BAR; PG8_WAIT_L(0); PG8_MMA(1, 0, At, B0); PG8_BAR; PG8_SCHED;
            PG8_STAGE(PG8_SB(1, 1), b3 + hstep, voffB);
            PG8_WAIT_V(6); PG8_BAR; PG8_MMA(1, 1, At, B1); PG8_BAR;
            }
        }
        if constexpr (ALIGN_EPI) { if (wr == 0) PG8_BAR; }
        if constexpr (!Epi::AFTER_DRAIN) { E(acc, cur, wr, wc, fr, fq); S.done(cur); }
        if (!has_next) break;
#pragma unroll
        for (int a = 0; a < 2; ++a)
#pragma unroll
            for (int b = 0; b < 2; ++b)
#pragma unroll
                for (int m = 0; m < 4; ++m)
#pragma unroll
                    for (int n = 0; n < 2; ++n) acc[a][b][m][n] = (f32x4){0.f, 0.f, 0.f, 0.f};
        cur = nxt; cA = nA; cB = nB; ++ui;
        if constexpr (ALIGN_EPI) { if (wr == 1) PG8_BAR; }
    }
    PG8_WAIT_V(0);
    if constexpr (!ALIGN_EPI) { if (wr == 0) PG8_BAR; }
    PG8_BAR;
    if constexpr (Epi::AFTER_DRAIN) { E.fused(acc, cur, wr, wc, fr, fq, lds, wid, lane); S.done(cur); }
#undef PG8_SA
#undef PG8_SB
#undef PG8_STAGE
#undef PG8_LDA
#undef PG8_LDB
#undef PG8_MMA
#undef PG8_WAIT_V
#undef PG8_WAIT_L
#undef PG8_BAR
#undef PG8_SCHED
}
}

#ifndef PG8_SP2
#define PG8_SP2 true
#endif
#ifndef PG8_ALIGN
#define PG8_ALIGN true
#endif
#include <hip/hip_bf16.h>
#include <cmath>
namespace attn_body {
using bf16=__hip_bfloat16;
using bf16x8=__attribute__((ext_vector_type(8)))short;
using s16x4=__attribute__((ext_vector_type(4)))short;
using f32x16=__attribute__((ext_vector_type(16)))float;
using u32x4=__attribute__((ext_vector_type(4)))unsigned;
constexpr int BATCH=2,NHEAD=16,SEQ=8192,D=64,PQ=3584,PO=1024;
constexpr int NW=8,QBLK=32,QB=QBLK*NW,KVBLK=64,NQB=SEQ/QB;
constexpr int ATTN_UNIT_ROWS=QB;
__device__ __forceinline__ int crow(int r,int hi){return (r&3)+8*(r>>2)+4*hi;}
#define SBAR() __builtin_amdgcn_sched_barrier(0)
__device__ __forceinline__ void cmask(f32x16&p0,f32x16&p1,int jb,int qrel,int hi){
  const float NEG=-INFINITY; int kb=64*jb+4*hi;
  #pragma unroll
  for(int r=0;r<16;++r){int kv=kb+(r&3)+8*(r>>2); if(kv>qrel)p0[r]=NEG; if(kv+32>qrel)p1[r]=NEG;}
}

constexpr int NSLOT=3, SLOTB=8192;
constexpr int LDS_K=0, LDS_V=NSLOT*SLOTB, LDS_WS=2*NSLOT*SLOTB, LDS_OST=LDS_WS+NW*64*4, LDS_BYTES=LDS_OST+NW*4096;
constexpr float C2=0.125f*1.4426950408889634f;
__device__ __forceinline__ void glds16(const void*gsrc,unsigned lds_dst){unsigned keep;
  asm volatile("s_mov_b32 %0, m0\n\ts_mov_b32 m0, %2\n\ts_nop 0\n\tglobal_load_lds_dwordx4 %1, off\n\ts_mov_b32 m0, %0":"=&s"(keep):"v"(gsrc),"s"(lds_dst):"memory");}
__device__ __forceinline__ float max3f(float a,float b,float c){float r;asm("v_max3_f32 %0, %1, %2, %3":"=v"(r):"v"(a),"v"(b),"v"(c));return r;}
__device__ __forceinline__ float max2f(float a,float b){float r;asm("v_max_f32_e32 %0, %1, %2":"=v"(r):"v"(a),"v"(b));return r;}
__device__ __forceinline__ float fadd_s(float a,float b){float r;asm("v_add_f32_e32 %0, %1, %2":"=v"(r):"v"(a),"v"(b));return r;}
__device__ __forceinline__ float fsub_s(float a,float b){float r;asm("v_sub_f32_e32 %0, %1, %2":"=v"(r):"v"(a),"v"(b));return r;}
typedef float f32x2_t __attribute__((ext_vector_type(2))); typedef __bf16 bf16x2_t __attribute__((ext_vector_type(2)));
__device__ __forceinline__ unsigned cvtpk_s(float lo,float hi){f32x2_t v={lo,hi};bf16x2_t b=__builtin_convertvector(v,bf16x2_t);return __builtin_bit_cast(unsigned,b);}
#define WAIT_BAR(N) asm volatile("s_waitcnt vmcnt(" #N ") lgkmcnt(0)\n\ts_barrier":::"memory")

__device__ __forceinline__ void qkt(f32x16&p0,f32x16&p1,const char*Kslot,const bf16x8*qr,const f32x16&negm,int r32,int hi){
  const char*kb=Kslot+hi*1024+r32*16;
  #pragma unroll
  for(int d0=0;d0<4;++d0){
    const bf16x8 b0=*reinterpret_cast<const bf16x8*>(kb+d0*2048);
    const bf16x8 b1=*reinterpret_cast<const bf16x8*>(kb+d0*2048+512);
    if(d0==0){p0=__builtin_amdgcn_mfma_f32_32x32x16_bf16(b0,qr[0],negm,0,0,0);p1=__builtin_amdgcn_mfma_f32_32x32x16_bf16(b1,qr[0],negm,0,0,0);}
    else{p0=__builtin_amdgcn_mfma_f32_32x32x16_bf16(b0,qr[d0],p0,0,0,0);p1=__builtin_amdgcn_mfma_f32_32x32x16_bf16(b1,qr[d0],p1,0,0,0);}}
}
typedef __attribute__((address_space(3))) const char* lds_cptr;
typedef short v4i16_t __attribute__((ext_vector_type(4)));
__device__ __forceinline__ void kload8(bf16x8*kf,lds_cptr kp){
  kf[0]=*(const __attribute__((address_space(3))) bf16x8*)(kp);      kf[1]=*(const __attribute__((address_space(3))) bf16x8*)(kp+512);
  kf[2]=*(const __attribute__((address_space(3))) bf16x8*)(kp+2048); kf[3]=*(const __attribute__((address_space(3))) bf16x8*)(kp+2560);
  kf[4]=*(const __attribute__((address_space(3))) bf16x8*)(kp+4096); kf[5]=*(const __attribute__((address_space(3))) bf16x8*)(kp+4608);
  kf[6]=*(const __attribute__((address_space(3))) bf16x8*)(kp+6144); kf[7]=*(const __attribute__((address_space(3))) bf16x8*)(kp+6656);
}
__device__ __forceinline__ void kload2(bf16x8*kf,lds_cptr kp,int j){ kf[2*j]=*(const __attribute__((address_space(3))) bf16x8*)(kp+j*2048); kf[2*j+1]=*(const __attribute__((address_space(3))) bf16x8*)(kp+j*2048+512); }
__device__ __forceinline__ s16x4 vtr(lds_cptr p){ return __builtin_bit_cast(s16x4,__builtin_amdgcn_ds_read_tr16_b64_v4i16((__attribute__((address_space(3))) v4i16_t*)p)); }
__device__ __forceinline__ float rowmax(const f32x16&p0,const f32x16&p1){
  float a=max3f(p0[0],p0[1],p1[0]),b=max3f(p0[2],p0[3],p1[1]);a=max3f(a,p1[2],p1[3]);
  #pragma unroll
  for(int r=4;r<16;r+=4){a=max3f(a,p0[r],p0[r+1]);b=max3f(b,p0[r+2],p0[r+3]);a=max3f(a,p1[r],p1[r+1]);b=max3f(b,p1[r+2],p1[r+3]);}
  const float m=max2f(a,b);
  auto rr=__builtin_amdgcn_permlane32_swap(__float_as_uint(m),__float_as_uint(m),false,false);
  return max2f(__uint_as_float(rr[0]),__uint_as_float(rr[1]));
}
__device__ __forceinline__ void pv(f32x16*o,int vb,bf16x8 pa0,bf16x8 pa1,bf16x8 pa2,bf16x8 pa3){
  #pragma unroll
  for(int d0=0;d0<2;++d0){s16x4 lo[4],hi[4];
    #pragma unroll
    for(int ks=0;ks<4;++ks){
      asm volatile("ds_read_b64_tr_b16 %0,%1 offset:%c2":"=&v"(lo[ks]):"v"(vb),"i"(d0*4096+ks*1024):"memory");
      asm volatile("ds_read_b64_tr_b16 %0,%1 offset:%c2":"=&v"(hi[ks]):"v"(vb),"i"(d0*4096+ks*1024+512):"memory");}
    asm volatile("s_waitcnt lgkmcnt(0)":::"memory");SBAR();
    #define PK(k) (bf16x8){lo[k][0],lo[k][1],lo[k][2],lo[k][3],hi[k][0],hi[k][1],hi[k][2],hi[k][3]}
    o[d0]=__builtin_amdgcn_mfma_f32_32x32x16_bf16(pa0,PK(0),o[d0],0,0,0);
    o[d0]=__builtin_amdgcn_mfma_f32_32x32x16_bf16(pa1,PK(1),o[d0],0,0,0);
    o[d0]=__builtin_amdgcn_mfma_f32_32x32x16_bf16(pa2,PK(2),o[d0],0,0,0);
    o[d0]=__builtin_amdgcn_mfma_f32_32x32x16_bf16(pa3,PK(3),o[d0],0,0,0);
    #undef PK
  }
}

#ifndef ATTN_STORE16
#define ATTN_STORE16(p,v) (*(u32x4*)(p)=(v))
#endif
constexpr int ATTN_LDS_BYTES=LDS_BYTES;
struct AttnTensors { const bf16* P; bf16* O; };
struct AttnUnit { int bh; int qb; };
constexpr int L2_K=0, L2_V=NSLOT*SLOTB, L2_WS=L2_V+NSLOT*2*SLOTB, L2_OST=L2_WS+NW*64*4, L2_BYTES=L2_OST+NW*4096;
__device__ __forceinline__ void attn_unit2(int b,int qb,const bf16*Q,const bf16*__restrict__ K,const bf16*__restrict__ V,bf16*O,char*shm){
  const int tid=threadIdx.x,lane=tid&63,r32=lane&31,hi=lane>>5; const int wid=__builtin_amdgcn_readfirstlane(tid>>6);
  const long rowbase=(long)b*SEQ; const int q0=qb*QB;
  const bf16*Qw=Q+(rowbase+q0+wid*QBLK)*PQ;
  const bf16*Kh=K+rowbase*PQ,*Vh=V+rowbase*PQ;
  const unsigned lds0=(unsigned)(uintptr_t)shm;
  float*wsf=(float*)(shm+L2_WS)+wid*64;
  const bf16*ksrc=Kh+(long)lane*PQ+wid*8;
  const bf16*vsrc=Vh+(long)(16*(wid&3)+(lane>>2))*PQ+(wid>>2)*32+(lane&3)*8;
  const unsigned kdst=lds0+L2_K+wid*1024, vdst=lds0+L2_V+wid*1024;
  #define DMA_K(t,slot) glds16(ksrc+(long)(t)*KVBLK*PQ,(unsigned)__builtin_amdgcn_readfirstlane(kdst+(slot)))
  #define DMA_V(t,slot) do{ glds16(vsrc+(long)(t)*KVBLK*PQ,(unsigned)__builtin_amdgcn_readfirstlane(vdst+2*(slot))); glds16(vsrc+(long)(t)*KVBLK*PQ+64,(unsigned)__builtin_amdgcn_readfirstlane(vdst+2*(slot)+8192)); }while(0)
  const int vb0=(int)(lds0+L2_V)+((lane>>4)&1)*32+(lane&3)*8+(4*hi+((lane&15)>>2))*64;
  const char*Kbase=shm+L2_K; bf16x8 kf[8];
  const lds_cptr shm3=(lds_cptr)shm; const lds_cptr kp0=shm3+L2_K+hi*1024+r32*16; const lds_cptr vp0=shm3+L2_V+((lane>>4)&1)*32+(lane&3)*8+(4*hi+((lane&15)>>2))*64;
  const int NT=(q0+QB)/KVBLK;
  DMA_K(0,0);DMA_V(0,0);DMA_K(1,SLOTB);
  bf16x8 qr[4];
  #pragma unroll
  for(int d0=0;d0<4;++d0)qr[d0]=*reinterpret_cast<const bf16x8*>(&Qw[(long)r32*PQ+d0*16+hi*8]);
  float l_reg=0.f;f32x16 o[4];o[0]=f32x16{};o[1]=f32x16{};o[2]=f32x16{};o[3]=f32x16{};const f32x16 zz=f32x16{};
  const int qrel=wid*QBLK+r32;
  #define CMASK(P0,P1,t) do{int jb_=(t)-(NT-4); if(jb_>=0)cmask(P0,P1,jb_,qrel,hi);}while(0)
  f32x16 pA0,pA1,pB0,pB1;
  int sl_prev=0,sl_cur=0,sl_next=SLOTB;
  #define ROT() do{sl_prev=sl_cur;sl_cur=sl_next;sl_next=(sl_next==(NSLOT-1)*SLOTB)?0:sl_next+SLOTB;}while(0)
  DMA_K(2,2*SLOTB);
  WAIT_BAR(4);
  qkt(pA0,pA1,Kbase,qr,zz,r32,hi);asm volatile("s_nop 15\n\ts_nop 7":"+v"(pA0),"+v"(pA1));CMASK(pA0,pA1,0);
  _Pragma("unroll") for(int r=0;r<16;++r)pA0[r]=__builtin_amdgcn_exp2f(pA0[r]);
  _Pragma("unroll") for(int r=0;r<16;++r)pA1[r]=__builtin_amdgcn_exp2f(pA1[r]);
  WAIT_BAR(0);
  DMA_K(3,0);DMA_V(1,SLOTB);
  ROT();
  kload8(kf,kp0+sl_cur);
  WAIT_BAR(3);
  s16x4 vlo[8],vhi[8]; u32x4 pw0,pw1,pw2,pw3;
  #define PKW(P,B) cvtpk_s(P[B],P[B+1])
  #define PAF(k) __builtin_bit_cast(bf16x8,pw##k)
  #define VFR(i) (bf16x8){vlo[i][0],vlo[i][1],vlo[i][2],vlo[i][3],vhi[i][0],vhi[i][1],vhi[i][2],vhi[i][3]}
  #define PIN(x) asm volatile("":"+v"(x))
  #define GAPA(MF,A0,A1,A2,A3,W0,W1,PW) do{ MF; sacc+=A0; sacc+=A1; sacc+=A2; sacc+=A3; PIN(sacc); W0; W1; PIN(PW); SBAR(); }while(0)
  #define EX(v) __builtin_amdgcn_exp2f(v)
  #define GAPB(MF,X,B) do{ MF; X[B]=EX(X[B]); X[B+1]=EX(X[B+1]); PIN(X); SBAR(); }while(0)
  #define VRD(i) do{ vlo[i]=vtr(vp_+(((i)>>2)*4096+((i)&3)*1024)); vhi[i]=vtr(vp_+(((i)>>2)*4096+((i)&3)*1024+512)); }while(0)
  #define VRB(i) do{ vlo[i]=vtr(vp_+(8192+((i)>>2)*4096+((i)&3)*1024)); vhi[i]=vtr(vp_+(8192+((i)>>2)*4096+((i)&3)*1024+512)); SBAR(); }while(0)
  #define KRD(G,j) do{ if(G){ kload2(kf,kp0+sl_next,j); SBAR(); } }while(0)
  #define STEP(C0,C1,P0,P1,t,GK,GV,GL) do{ SBAR(); \
    const lds_cptr vp_=vp0+2*sl_prev; \
    VRD(0); SBAR(); float sacc=(P0[0]+P0[1]); \
    GAPA(C0=__builtin_amdgcn_mfma_f32_32x32x16_bf16(kf[0],qr[0],zz,0,0,0), P0[2],P0[3],P0[4],P0[5],     pw0[0]=PKW(P0,0), pw0[1]=PKW(P0,2), pw0); \
    VRD(4); SBAR(); GAPA(C1=__builtin_amdgcn_mfma_f32_32x32x16_bf16(kf[1],qr[0],zz,0,0,0), P0[6],P0[7],P0[8],P0[9],     pw0[2]=PKW(P0,4), pw0[3]=PKW(P0,6), pw0); \
    VRD(1); SBAR(); GAPA(C0=__builtin_amdgcn_mfma_f32_32x32x16_bf16(kf[2],qr[1],C0,0,0,0),   P0[10],P0[11],P0[12],P0[13], pw1[0]=PKW(P0,8), pw1[1]=PKW(P0,10), pw1); \
    VRD(5); SBAR(); GAPA(C1=__builtin_amdgcn_mfma_f32_32x32x16_bf16(kf[3],qr[1],C1,0,0,0),   P0[14],P0[15],P1[0],P1[1],   pw1[2]=PKW(P0,12),pw1[3]=PKW(P0,14), pw1); \
    VRD(2); SBAR(); GAPA(C0=__builtin_amdgcn_mfma_f32_32x32x16_bf16(kf[4],qr[2],C0,0,0,0),   P1[2],P1[3],P1[4],P1[5],     pw2[0]=PKW(P1,0), pw2[1]=PKW(P1,2), pw2); \
    VRD(6); SBAR(); GAPA(C1=__builtin_amdgcn_mfma_f32_32x32x16_bf16(kf[5],qr[2],C1,0,0,0),   P1[6],P1[7],P1[8],P1[9],     pw2[2]=PKW(P1,4), pw2[3]=PKW(P1,6), pw2); \
    VRD(3); SBAR(); GAPA(C0=__builtin_amdgcn_mfma_f32_32x32x16_bf16(kf[6],qr[3],C0,0,0,0),   P1[10],P1[11],P1[12],P1[13], pw3[0]=PKW(P1,8), pw3[1]=PKW(P1,10), pw3); \
    VRD(7); SBAR(); GAPA(C1=__builtin_amdgcn_mfma_f32_32x32x16_bf16(kf[7],qr[3],C1,0,0,0),   P1[14],P1[15],0.f,0.f,       pw3[2]=PKW(P1,12),pw3[3]=PKW(P1,14), pw3); \
    l_reg+=sacc; \
    if(GK){DMA_K((t)+3,sl_cur);} if(GV){DMA_V((t)+1,sl_next);} \
    CMASK(C0,C1,t); \
    SBAR(); \
    GAPB(o[0]=__builtin_amdgcn_mfma_f32_32x32x16_bf16(PAF(0),VFR(0),o[0],0,0,0), C0,0);  VRB(0); \
    GAPB(o[1]=__builtin_amdgcn_mfma_f32_32x32x16_bf16(PAF(0),VFR(4),o[1],0,0,0), C0,2);  VRB(4); \
    GAPB(o[0]=__builtin_amdgcn_mfma_f32_32x32x16_bf16(PAF(1),VFR(1),o[0],0,0,0), C0,4);  VRB(1); \
    GAPB(o[1]=__builtin_amdgcn_mfma_f32_32x32x16_bf16(PAF(1),VFR(5),o[1],0,0,0), C0,6);  VRB(5); \
    GAPB(o[0]=__builtin_amdgcn_mfma_f32_32x32x16_bf16(PAF(2),VFR(2),o[0],0,0,0), C0,8);  VRB(2); \
    GAPB(o[1]=__builtin_amdgcn_mfma_f32_32x32x16_bf16(PAF(2),VFR(6),o[1],0,0,0), C0,10); VRB(6); \
    GAPB(o[0]=__builtin_amdgcn_mfma_f32_32x32x16_bf16(PAF(3),VFR(3),o[0],0,0,0), C0,12); VRB(3); \
    GAPB(o[1]=__builtin_amdgcn_mfma_f32_32x32x16_bf16(PAF(3),VFR(7),o[1],0,0,0), C0,14); VRB(7); \
    GAPB(o[2]=__builtin_amdgcn_mfma_f32_32x32x16_bf16(PAF(0),VFR(0),o[2],0,0,0), C1,0); \
    GAPB(o[3]=__builtin_amdgcn_mfma_f32_32x32x16_bf16(PAF(0),VFR(4),o[3],0,0,0), C1,2); \
    KRD(GL,0); GAPB(o[2]=__builtin_amdgcn_mfma_f32_32x32x16_bf16(PAF(1),VFR(1),o[2],0,0,0), C1,4); \
    KRD(GL,1); GAPB(o[3]=__builtin_amdgcn_mfma_f32_32x32x16_bf16(PAF(1),VFR(5),o[3],0,0,0), C1,6); \
    KRD(GL,2); GAPB(o[2]=__builtin_amdgcn_mfma_f32_32x32x16_bf16(PAF(2),VFR(2),o[2],0,0,0), C1,8); \
    KRD(GL,3); GAPB(o[3]=__builtin_amdgcn_mfma_f32_32x32x16_bf16(PAF(2),VFR(6),o[3],0,0,0), C1,10); \
    GAPB(o[2]=__builtin_amdgcn_mfma_f32_32x32x16_bf16(PAF(3),VFR(3),o[2],0,0,0), C1,12); \
    GAPB(o[3]=__builtin_amdgcn_mfma_f32_32x32x16_bf16(PAF(3),VFR(7),o[3],0,0,0), C1,14); \
    }while(0)
  int t=1;
  #undef CMASK
  #define CMASK(P0,P1,t) do{}while(0)
  for(;t+5<NT;t+=2){
    STEP(pB0,pB1,pA0,pA1,t,true,true,true);     WAIT_BAR(3); ROT();
    STEP(pA0,pA1,pB0,pB1,t+1,true,true,true);   WAIT_BAR(3); ROT();
  }
  #undef CMASK
  #define CMASK(P0,P1,t) do{int jb_=(t)-(NT-4); if(jb_>=0)cmask(P0,P1,jb_,qrel,hi);}while(0)
  #define ENDW(tt) do{ if((tt)+3<NT){WAIT_BAR(3);} else if((tt)+2<NT){WAIT_BAR(2);} else {WAIT_BAR(0);} }while(0)
  for(;t+1<NT;t+=2){
    STEP(pB0,pB1,pA0,pA1,t,(t+3<NT),(t+1<NT),(t+1<NT));       ENDW(t);   ROT();
    STEP(pA0,pA1,pB0,pB1,t+1,(t+4<NT),(t+2<NT),(t+2<NT));     ENDW(t+1); ROT();
  }
  STEP(pB0,pB1,pA0,pA1,NT-1,false,false,false);
  { float sacc=pB0[0]+pB0[1]; _Pragma("unroll") for(int r=2;r<16;++r)sacc+=pB0[r]; _Pragma("unroll") for(int r=0;r<16;++r)sacc+=pB1[r]; l_reg+=sacc;
    pw0=(u32x4){PKW(pB0,0),PKW(pB0,2),PKW(pB0,4),PKW(pB0,6)};pw1=(u32x4){PKW(pB0,8),PKW(pB0,10),PKW(pB0,12),PKW(pB0,14)};pw2=(u32x4){PKW(pB1,0),PKW(pB1,2),PKW(pB1,4),PKW(pB1,6)};pw3=(u32x4){PKW(pB1,8),PKW(pB1,10),PKW(pB1,12),PKW(pB1,14)};
    SBAR(); pv(o,vb0+2*sl_cur,PAF(0),PAF(1),PAF(2),PAF(3)); pv(o+2,vb0+2*sl_cur+8192,PAF(0),PAF(1),PAF(2),PAF(3)); }
  #undef PKW
  #undef PAF
  #undef VFR
  #undef PIN
  #undef GAPA
  #undef GAPB
  #undef EX
  #undef VRD
  #undef VRB
  #undef KRD
  #undef STEP
  #undef ENDW
  {auto rr=__builtin_amdgcn_permlane32_swap(__float_as_uint(l_reg),__float_as_uint(l_reg),false,false);l_reg=__uint_as_float(rr[0])+__uint_as_float(rr[1]);}
  if(hi==0)wsf[32+r32]=l_reg;asm volatile("s_waitcnt lgkmcnt(0)":::"memory");
  float rli[16];
  #pragma unroll
  for(int r=0;r<16;++r)rli[r]=__builtin_amdgcn_rcpf(wsf[32+crow(r,hi)]);
  bf16*Ow=O+(rowbase+q0+wid*QBLK)*PO;
  { bf16*stg=(bf16*)(shm+L2_OST)+wid*2048;
    #pragma unroll
    for(int hh=0;hh<2;++hh){
      #pragma unroll
      for(int r=0;r<16;++r){const int orow=crow(r,hi);
        #pragma unroll
        for(int d0=0;d0<2;++d0)stg[orow*64+d0*32+r32]=__float2bfloat16(o[2*hh+d0][r]*rli[r]);}
      asm volatile("s_waitcnt lgkmcnt(0)":::"memory");
      #pragma unroll
      for(int i=0;i<4;++i){const int row=i*8+(lane>>3),ch=lane&7; const u32x4 v=*(const u32x4*)(stg+row*64+ch*8); ATTN_STORE16(Ow+(long)row*PO+hh*64+ch*8,v);}
      asm volatile("s_waitcnt lgkmcnt(0)":::"memory"); } }
  asm volatile("s_waitcnt lgkmcnt(0)\n\ts_barrier":::"memory");
  #undef DMA_K
  #undef DMA_V
  #undef CMASK
  #undef ROT
}
struct StaticOrder2 {
  int vcu;
  __device__ __forceinline__ explicit StaticOrder2(int grid,int block):vcu((block%8)*(grid/8)+block/8){}
  __device__ __forceinline__ bool next(int i,AttnUnit&u)const{ if(i>=2)return false; const int s=vcu&15; u.bh=vcu>>4; u.qb=(i==0)?s:31-s; return true; }
};
__device__ __forceinline__ void attn_phase2(char*lds,const AttnTensors&T,const StaticOrder2&S){
  AttnUnit u;
  for(int i=0;S.next(i,u);++i){ const int b=u.bh>>3, hm=u.bh&7; attn_unit2(b,u.qb,T.P+2048+hm*64,T.P+2560+hm*64,T.P+3072+(hm>>1)*128,T.O+hm*128,lds); }
}
#undef SBAR
#undef WAIT_BAR
}
constexpr int NWAVES = 8;
constexpr int PER_PHASE = 8;
constexpr int T = 8192, D = 1024, M = 16384, NIN = 3584, FF = 2816, NGU = 5632;
constexpr float EPSN = 1e-6f;
constexpr size_t MiB = 1u << 20;
constexpr size_t WS_CTL = 0, CTL_ZERO_BYTES = 32768;
constexpr size_t WS_WIN = 2 * MiB, WS_WOUT = 9 * MiB, WS_WGU = 11 * MiB, WS_WDN = 22 * MiB;
constexpr size_t WS_ROPEC = 28 * MiB, WS_ROPES = 29 * MiB, WS_RSTD1 = 30 * MiB, WS_SS2 = 31 * MiB;
constexpr size_t WS_XN = 32 * MiB;
constexpr size_t WS_KV = 32 * MiB;
constexpr size_t WS_P = 64 * MiB;
constexpr size_t WS_H = 64 * MiB;
constexpr size_t WS_O = 176 * MiB, WS_MIX = 208 * MiB, WS_END = 240 * MiB;
static_assert(WS_WDN + (size_t)D * FF * 2 <= WS_ROPEC && WS_P + (size_t)M * NIN * 2 <= WS_O && WS_H + (size_t)M * FF * 2 <= WS_O && WS_KV + (size_t)1024 * 4096 * 4 <= WS_P, "d_ws map");
constexpr int CW_TMO = 0, CW_CODE = 1, CW_BAR = 4096;
static_assert((CW_BAR + 3456) * 4 <= (int)CTL_ZERO_BYTES, "barrier words inside the per-call memset");
constexpr int RING_OFF = 0, RING_BYTES = 131072;
constexpr int LDSCTL_OFF = RING_BYTES, MISC_OFF = LDSCTL_OFF + 320;
constexpr int LDS_BYTES = 147456;
#define GAS __attribute__((address_space(1)))
#define LAS __attribute__((address_space(3)))
typedef unsigned short bf16;
typedef unsigned v4u __attribute__((ext_vector_type(4)));
typedef float f32x4 __attribute__((ext_vector_type(4)));
typedef short bf16x8 __attribute__((ext_vector_type(8)));
typedef GAS unsigned gu32;
typedef GAS unsigned long long gu64;
#define RLX_AGENT __ATOMIC_RELAXED, __HIP_MEMORY_SCOPE_AGENT
#define LDS_WAIT() asm volatile("s_waitcnt lgkmcnt(0)" ::: "memory")
#define VM_WAIT() asm volatile("s_waitcnt vmcnt(0)" ::: "memory")
__device__ __forceinline__ unsigned long long rt() { return __builtin_amdgcn_s_memrealtime(); }
typedef float f32x2_cv __attribute__((ext_vector_type(2))); typedef __bf16 bf16x2_cv __attribute__((ext_vector_type(2)));
__device__ __forceinline__ unsigned pk2(float lo, float hi) { const f32x2_cv v = {lo, hi}; return __builtin_bit_cast(unsigned, __builtin_convertvector(v, bf16x2_cv)); }
__device__ __forceinline__ unsigned f2bf(float f) { return pk2(f, 0.f) & 0xffffu; }

#define XB_TMO      128
#define XB_XCNT(j)  (256  + 64 * (j))
#define XB_XSUB(j)  (1280 + 64 * (j))
#define XB_XGEN(j)  (2304 + 64 * (j))
#define XB_TOP      3328
#define XB_TOPGEN   3392
#define XCD_BAR_WORDS 3456
#define XB_SPIN_CAP (1u << 18)

__device__ __forceinline__ unsigned xb_ld(unsigned* p)              { return __hip_atomic_load(p, __ATOMIC_RELAXED, __HIP_MEMORY_SCOPE_AGENT); }
__device__ __forceinline__ unsigned xb_add(unsigned* p, unsigned v) { return __hip_atomic_fetch_add(p, v, __ATOMIC_RELAXED, __HIP_MEMORY_SCOPE_AGENT); }
__device__ __forceinline__ unsigned xb_xcc_id() { return (unsigned)__builtin_amdgcn_s_getreg((3 << 11) | 20) & 0xFu; }
#define XB_SPIN(cond, bar) do { unsigned _sp = 0; while (cond) { __builtin_amdgcn_s_sleep(1); \
    if ((++_sp & 255u) == 0u) { if (xb_ld(&(bar)[XB_TMO])) break; if (_sp > XB_SPIN_CAP) { atomicAdd(&(bar)[XB_TMO], 1u); break; } } } } while (0)

struct XcdBarrier {
    unsigned* bar; unsigned x;
    volatile LAS unsigned* st;
};

__device__ __forceinline__ XcdBarrier xcd_barrier_post(unsigned* bar, volatile LAS unsigned* st) {
    XcdBarrier b; b.bar = bar; b.x = xb_xcc_id(); b.st = st;
    if (threadIdx.x == 0) (void)xb_add(&bar[XB_XCNT(b.x)], 1u);
    return b;
}
__device__ __forceinline__ void xcd_barrier_complete(unsigned* bar, unsigned x, unsigned& nloc, unsigned& nx) {
    const unsigned G = gridDim.x * gridDim.y * gridDim.z;
    unsigned sum, cnt, mine, sp = 0u;
    for (;;) {
        sum = 0u; cnt = 0u; mine = 0u;
#pragma unroll
        for (unsigned j = 0; j < 16; ++j) { const unsigned c = xb_ld(&bar[XB_XCNT(j)]); sum += c; cnt += (c > 0u) ? 1u : 0u; mine = (j == x) ? c : mine; }
        if (sum == G) break;
        __builtin_amdgcn_s_sleep(1);
        if ((++sp & 255u) == 0u) { if (xb_ld(&bar[XB_TMO])) break; if (sp > XB_SPIN_CAP) { atomicAdd(&bar[XB_TMO], 1u); break; } }
    }
    nloc = mine > 0u ? mine : 1u; nx = cnt > 0u ? cnt : 1u;
}

__device__ __forceinline__ void xcd_barrier(const XcdBarrier& b) {
    asm volatile("s_waitcnt vmcnt(0)" ::: "memory");
    __syncthreads();
    if (threadIdx.x == 0) {
        unsigned* bar = b.bar;
        __builtin_amdgcn_s_waitcnt(0);
        unsigned nloc = b.st[0], nx = b.st[1];
        if (nloc == 0u) { xcd_barrier_complete(bar, b.x, nloc, nx); b.st[0] = nloc; b.st[1] = nx; }
        const unsigned old = xb_add(&bar[XB_XSUB(b.x)], 1u);
        const unsigned gen = old / nloc;
        if (old + 1u == (gen + 1u) * nloc) {
            __builtin_amdgcn_fence(__ATOMIC_RELEASE, "agent");
            asm volatile("s_waitcnt vmcnt(0)" ::: "memory");
            const unsigned og = xb_add(&bar[XB_TOP], 1u);
            const unsigned tg = og / nx;
            if (og + 1u == (tg + 1u) * nx) xb_add(&bar[XB_TOPGEN], 1u);
            else XB_SPIN(xb_ld(&bar[XB_TOPGEN]) == tg, bar);
            __builtin_amdgcn_fence(__ATOMIC_ACQUIRE, "agent");
            xb_add(&bar[XB_XGEN(b.x)], 1u);
            asm volatile("s_waitcnt vmcnt(0)" ::: "memory");
        } else {
            XB_SPIN(xb_ld(&bar[XB_XGEN(b.x)]) == gen, bar);
            __builtin_amdgcn_fence(__ATOMIC_ACQUIRE, "agent");
            asm volatile("s_waitcnt vmcnt(0)" ::: "memory");
        }
    }
    __syncthreads();
}
struct Frame {
    LAS unsigned char* lds;
    volatile LAS unsigned* MISC;
    gu32* ctl;
    int tid, lane, wave;
    int vcu, G;
    const float *x, *g1, *w_in, *retg, *gq, *gk, *lq1, *lk1, *lq2, *lk2, *gsub, *w_out, *g2, *w_gate, *w_up, *w_down;
    float* out;
    bf16 *Win_t, *Wout_t, *Wgu_t, *Wdn_t;
    float *ropec, *ropes, *rstd1, *ss2, *KV;
    bf16 *XN, *P, *HB, *O, *MIX;
};
__device__ __forceinline__ float wave_sum_bperm(float v) {
#pragma unroll
    for (int o = 1; o < 64; o <<= 1) v += __shfl_xor(v, o);
    return v;
}
__device__ __forceinline__ float bflo(unsigned w) { return __uint_as_float(w << 16); }
__device__ __forceinline__ float bfhi(unsigned w) { return __uint_as_float(w & 0xffff0000u); }
template <int CTRL> __device__ __forceinline__ float dpp_mov(float v) { return __int_as_float(__builtin_amdgcn_update_dpp(0, __float_as_int(v), CTRL, 0xF, 0xF, true)); }
__device__ __forceinline__ float sum16(float v) {
    v += dpp_mov<0xB1>(v); v += dpp_mov<0x4E>(v); v += dpp_mov<0x141>(v); v += dpp_mov<0x140>(v); return v;
}
__device__ __forceinline__ float wave_sum(float v) { return pg8::sum_rows4(sum16(v)); }
__device__ __forceinline__ float ret_lg2(int h) {
    const float xx = __builtin_amdgcn_exp2f(-(float)(5 + h));
    float p = 0.125f; p = p * xx + (1.f / 7.f); p = p * xx + (1.f / 6.f); p = p * xx + 0.2f; p = p * xx + 0.25f; p = p * xx + (1.f / 3.f); p = p * xx + 0.5f; p = p * xx + 1.f;
    return -xx * p * 1.4426950408889634f;
}
__device__ __forceinline__ void p0_transpose_item(const float* W, int K, int N, bf16* WT, int mode, const float* kscale, LAS unsigned short* scr, int item, int lane) {
    const int nblk = N / 64, kb = item / nblk, nb = item % nblk, k0 = 64 * kb, n0 = 64 * nb;
    const int c = lane & 15, kr = lane >> 4;
    f32x4 v[16];
#pragma unroll
    for (int i = 0; i < 16; ++i) v[i] = *(const GAS f32x4*)(W + (size_t)(k0 + 4 * i + kr) * N + n0 + 4 * c);
#pragma unroll
    for (int i = 0; i < 16; ++i) { const int k = 4 * i + kr; const float sc = kscale ? kscale[k0 + k] : 1.f; LAS unsigned short* p = scr + (4 * c) * 72 + k;
        p[0] = (unsigned short)f2bf(v[i].x * sc); p[72] = (unsigned short)f2bf(v[i].y * sc); p[144] = (unsigned short)f2bf(v[i].z * sc); p[216] = (unsigned short)f2bf(v[i].w * sc); }
    LDS_WAIT(); asm volatile("" ::: "memory");
    int obase;
    if (mode == 1) obase = (n0 & ~255) + (((n0 & 255) >> 6) * 32);
    else if (mode == 2) obase = (n0 >> 7) * 256 + (n0 & 127);
    else if (mode == 3) obase = (n0 >> 7) * 256 + 128 + (n0 & 127);
    else obase = n0;
    const int hstep = (mode == 1) ? 128 : 32, ch = lane & 7;
#pragma unroll
    for (int j = 0; j < 8; ++j) { const int n = 8 * j + (lane >> 3); const v4u o = *(const LAS v4u*)(scr + n * 72 + 8 * ch);
        const int orow = obase + (n >> 5) * hstep + (n & 31);
        *(GAS v4u*)(WT + (size_t)orow * K + k0 + 8 * ch) = o; }
    LDS_WAIT(); asm volatile("" ::: "memory");
}
__device__ __forceinline__ void p0_prologue(Frame& F) {
    LAS unsigned short* scr = (LAS unsigned short*)(F.lds + F.wave * 16384);
    const int gw = F.vcu * NWAVES + F.wave, NGW = F.G * NWAVES;
    constexpr int I_IN = (D / 64) * (NIN / 64);
    for (int it = gw; it < I_IN; it += NGW) p0_transpose_item(F.w_in, D, NIN, F.Win_t, 1, F.g1, scr, it, F.lane);
    for (int m = gw; m < M; m += 2 * NGW) {
        const int m2 = (m + NGW < M) ? m + NGW : m;
        const GAS f32x4* xa = (const GAS f32x4*)(F.x + (size_t)m * D) + F.lane; const GAS f32x4* xb = (const GAS f32x4*)(F.x + (size_t)m2 * D) + F.lane; f32x4 va[4], vb[4]; float sa = 0.f, sb = 0.f;
#pragma unroll
        for (int j = 0; j < 4; ++j) { va[j] = __builtin_nontemporal_load(xa + 64 * j); vb[j] = __builtin_nontemporal_load(xb + 64 * j); }
#pragma unroll
        for (int j = 0; j < 4; ++j) { sa += (va[j].x * va[j].x + va[j].y * va[j].y) + (va[j].z * va[j].z + va[j].w * va[j].w); sb += (vb[j].x * vb[j].x + vb[j].y * vb[j].y) + (vb[j].z * vb[j].z + vb[j].w * vb[j].w); }
        sa = wave_sum(sa); sb = wave_sum(sb);
        GAS unsigned long long* oa = (GAS unsigned long long*)(F.XN + (size_t)m * D) + F.lane; GAS unsigned long long* ob = (GAS unsigned long long*)(F.XN + (size_t)m2 * D) + F.lane;
#pragma unroll
        for (int j = 0; j < 4; ++j) { oa[64 * j] = (unsigned long long)pk2(va[j].x, va[j].y) | ((unsigned long long)pk2(va[j].z, va[j].w) << 32);
            ob[64 * j] = (unsigned long long)pk2(vb[j].x, vb[j].y) | ((unsigned long long)pk2(vb[j].z, vb[j].w) << 32); }
        if (F.lane == 0) { F.rstd1[m] = rsqrtf(sa * (1.f / D) + EPSN); F.rstd1[m2] = rsqrtf(sb * (1.f / D) + EPSN); }
    }
    for (int i = gw * 64 + F.lane; i < T * 32; i += NGW * 64) {
        const int pos = i >> 5, fi = i & 31;
        const float freq = __builtin_amdgcn_exp2f(-(float)fi * (13.287712379549449f / 32.0f));
        const double rev = (double)pos * (double)freq * 0.15915494309189535;
        const float fr = (float)(rev - __builtin_floor(rev));
        F.ropec[i] = __builtin_amdgcn_cosf(fr); F.ropes[i] = __builtin_amdgcn_sinf(fr);
    }
}
typedef float f32x16 __attribute__((ext_vector_type(16)));
constexpr int RL_Q = 0, RL_K = 18432, RL_KT = 36864, RL_OF = RL_K, RL_VT = 54272, RL_AM = 71680, RL_ST = 106496;
__device__ __forceinline__ int crow16(int r, int hi) { return (r & 3) + 8 * (r >> 2) + 4 * hi; }
__device__ __forceinline__ bf16x8 rfrag(const LAS unsigned char* p) { return *(const LAS bf16x8*)p; }
__device__ __forceinline__ void p0_deferred(Frame& F) {
    LAS unsigned short* scr = (LAS unsigned short*)(F.lds + F.wave * 16384);
    const int nb = (int)F.G - 128; if (nb <= 0 || (int)blockIdx.x < 128) return;
    const int gw = ((int)blockIdx.x - 128) * NWAVES + F.wave, NGW = nb * NWAVES;
    constexpr int I_OUT = (D / 64) * (D / 64), I_G = (D / 64) * (FF / 64), I_DN = (FF / 64) * (D / 64);
    for (int it = gw; it < I_OUT + 2 * I_G + I_DN; it += NGW) {
        int r = it;
        if (r < I_OUT) { p0_transpose_item(F.w_out, D, D, F.Wout_t, 0, nullptr, scr, r, F.lane); continue; } r -= I_OUT;
        if (r < I_G) { p0_transpose_item(F.w_gate, D, FF, F.Wgu_t, 2, F.g2, scr, r, F.lane); continue; } r -= I_G;
        if (r < I_G) { p0_transpose_item(F.w_up, D, FF, F.Wgu_t, 3, F.g2, scr, r, F.lane); continue; } r -= I_G;
        p0_transpose_item(F.w_down, FF, D, F.Wdn_t, 0, nullptr, scr, r, F.lane);
    }
}
typedef unsigned u32x2g __attribute__((ext_vector_type(2)));
struct RetRegs { v4u a[8]; u32x2g g[4]; };
__device__ __forceinline__ void ret_load(RetRegs& R, const bf16* Pb, int tid, bool withQ) {
#pragma unroll
    for (int c = 0; c < 8; ++c) R.a[c] = (v4u){0u, 0u, 0u, 0u};
#pragma unroll
    for (int c = 0; c < 4; ++c) R.g[c] = (u32x2g){0u, 0u};
    if (tid < 256) { const bf16* p = Pb + (size_t)(tid & 127) * NIN + (tid < 128 ? 512 : 1024);
#pragma unroll
        for (int c8 = 0; c8 < 8; ++c8) R.a[c8] = *(const GAS v4u*)(p + 8 * c8); }
    else if (withQ) { const int t = tid - 256; const bf16* p = Pb + (size_t)(t >> 1) * NIN + 32 * (t & 1);
#pragma unroll
        for (int c = 0; c < 4; ++c) R.a[c] = *(const GAS v4u*)(p + 8 * c); }
    if (withQ) {
#pragma unroll
        for (int rr = 0; rr < 4; ++rr) R.g[rr] = *(const GAS u32x2g*)(Pb + (size_t)(4 * (tid >> 4) + rr) * NIN + 1536 + 4 * (tid & 15)); }
}
__device__ __forceinline__ void ret_store(Frame& F, const RetRegs& R, float lg2, bool withQ) {
    LAS unsigned char* L = F.lds; const int tid = F.tid;
    if (tid < 128) { const int j = tid; const float sc = __builtin_amdgcn_exp2f(-lg2 * (float)j);
#pragma unroll
        for (int c8 = 0; c8 < 8; ++c8) { const v4u kk = R.a[c8];
            v4u kp; kp.x = pk2(bflo(kk.x) * sc, bfhi(kk.x) * sc); kp.y = pk2(bflo(kk.y) * sc, bfhi(kk.y) * sc); kp.z = pk2(bflo(kk.z) * sc, bfhi(kk.z) * sc); kp.w = pk2(bflo(kk.w) * sc, bfhi(kk.w) * sc);
            *(LAS v4u*)(L + RL_K + j * 144 + c8 * 16) = kp;
            LAS unsigned short* kt = (LAS unsigned short*)(L + RL_KT) + (8 * c8) * 136 + j;
            kt[0] = (unsigned short)kp.x; kt[136] = (unsigned short)(kp.x >> 16); kt[272] = (unsigned short)kp.y; kt[408] = (unsigned short)(kp.y >> 16);
            kt[544] = (unsigned short)kp.z; kt[680] = (unsigned short)(kp.z >> 16); kt[816] = (unsigned short)kp.w; kt[952] = (unsigned short)(kp.w >> 16); } }
    else if (tid < 256) { const int j = tid - 128;
#pragma unroll
        for (int c8 = 0; c8 < 8; ++c8) { const v4u vv = R.a[c8]; LAS unsigned short* vt = (LAS unsigned short*)(L + RL_VT) + (8 * c8) * 136 + j;
            vt[0] = (unsigned short)vv.x; vt[136] = (unsigned short)(vv.x >> 16); vt[272] = (unsigned short)vv.y; vt[408] = (unsigned short)(vv.y >> 16);
            vt[544] = (unsigned short)vv.z; vt[680] = (unsigned short)(vv.z >> 16); vt[816] = (unsigned short)vv.w; vt[952] = (unsigned short)(vv.w >> 16); } }
    else if (withQ) { const int t = tid - 256, i = t >> 1, hq = t & 1; const float sq = __builtin_amdgcn_exp2f(lg2 * (float)i);
#pragma unroll
        for (int c = 0; c < 4; ++c) { const v4u qq = R.a[c];
            v4u qp; qp.x = pk2(bflo(qq.x) * sq, bfhi(qq.x) * sq); qp.y = pk2(bflo(qq.y) * sq, bfhi(qq.y) * sq); qp.z = pk2(bflo(qq.z) * sq, bfhi(qq.z) * sq); qp.w = pk2(bflo(qq.w) * sq, bfhi(qq.w) * sq);
            *(LAS v4u*)(L + RL_Q + i * 144 + (4 * hq + c) * 16) = qp; } }
}
__device__ __forceinline__ f32x16 ret_kv_tile(Frame& F, int dt, int et) {
    const int r32 = F.lane & 31, hi = F.lane >> 5; f32x16 kv = {};
    const LAS unsigned char* ap = F.lds + RL_KT + (32 * dt + r32) * 272 + hi * 16; const LAS unsigned char* bp = F.lds + RL_VT + (32 * et + r32) * 272 + hi * 16;
#pragma unroll
    for (int jk = 0; jk < 8; ++jk) kv = __builtin_amdgcn_mfma_f32_32x32x16_bf16(rfrag(ap + jk * 32), rfrag(bp + jk * 32), kv, 0, 0, 0);
    return kv;
}
#define RET_BAR() asm volatile("s_waitcnt lgkmcnt(0)\n\ts_barrier" ::: "memory")
__device__ __forceinline__ void ret_state_unit(Frame& F, int bh, int n4) {
    const int b = bh >> 3, h = bh & 7, w = F.wave, r32 = F.lane & 31, hi = F.lane >> 5, dt = (w >> 1) & 1, et = w & 1;
    const float lg2 = ret_lg2(h), cd = __builtin_amdgcn_exp2f(lg2 * 128.f), g127 = __builtin_amdgcn_exp2f(lg2 * 127.f);
    f32x16 Sr = {};
    const bf16* Pb0 = F.P + ((size_t)b * T + (4 * n4) * 128) * NIN + h * 64;
    RetRegs R; ret_load(R, Pb0, F.tid, false);
    for (int c = 0; c < 4; ++c) {
        ret_store(F, R, lg2, false);
        if (c < 3) ret_load(R, Pb0 + (size_t)(c + 1) * 128 * NIN, F.tid, false);
        RET_BAR();
        if (w < 4) { const f32x16 kv = ret_kv_tile(F, dt, et); Sr = Sr * cd + kv * g127; }
        RET_BAR();
    }
    if (w < 4) { float* gp = F.KV + (size_t)(bh * 16 + n4) * 4096 + (32 * dt) * 64 + 32 * et + r32;
#pragma unroll
        for (int r = 0; r < 16; ++r) gp[crow16(r, hi) * 64] = Sr[r]; }
}
__device__ __forceinline__ void ret_unit(Frame& F, int bh, int n4) {
    typedef unsigned u32x2 __attribute__((ext_vector_type(2)));
    const int b = bh >> 3, h = bh & 7, tid = F.tid, w = F.wave, r32 = F.lane & 31, hi = F.lane >> 5;
    LAS unsigned char* L = F.lds;
    const float lg2 = ret_lg2(h), cd = __builtin_amdgcn_exp2f(lg2 * 128.f), g127 = __builtin_amdgcn_exp2f(lg2 * 127.f), gam = __builtin_amdgcn_exp2f(lg2), cd4 = __builtin_amdgcn_exp2f(lg2 * 512.f);
    const int dt = (w >> 1) & 1, et = w & 1;
    f32x16 Sr = {};
    const bf16* Pb0 = F.P + ((size_t)b * T + (4 * n4) * 128) * NIN + h * 64;
    RetRegs R; ret_load(R, Pb0, tid, true);
    {
        const float* gp = F.KV + (size_t)(bh * 16) * 4096 + tid * 8; f32x4 s0 = {0.f, 0.f, 0.f, 0.f}, s1 = s0; float wgt = 1.f;
#pragma unroll 4
        for (int m = n4 - 1; m >= 0; --m) { const f32x4 a0 = *(const GAS f32x4*)(gp + (size_t)m * 4096), a1 = *(const GAS f32x4*)(gp + (size_t)m * 4096 + 4); s0 += a0 * wgt; s1 += a1 * wgt; wgt *= cd4; }
        LAS float* sf = (LAS float*)(L + RL_AM);
        *(LAS f32x4*)(sf + tid * 8) = s0; *(LAS f32x4*)(sf + tid * 8 + 4) = s1;
        RET_BAR();
        if (w < 4) {
#pragma unroll
            for (int r = 0; r < 16; ++r) Sr[r] = sf[(32 * dt + crow16(r, hi)) * 64 + 32 * et + r32];
            LAS unsigned short* st = (LAS unsigned short*)(L + RL_ST) + (32 * et + r32) * 72 + 32 * dt;
#pragma unroll
            for (int r = 0; r < 16; ++r) st[crow16(r, hi)] = (unsigned short)f2bf(Sr[r]);
        }
        RET_BAR();
    }
    const f32x4 g4 = *(const f32x4*)(F.retg + h * 64 + 4 * (tid & 15));
    for (int c = 0; c < 4; ++c) {
        const size_t r0 = (size_t)b * T + (4 * n4 + c) * 128; const bf16* Pb = F.P + r0 * NIN + h * 64;
        ret_store(F, R, lg2, true);
        const u32x2g gcur[4] = {R.g[0], R.g[1], R.g[2], R.g[3]};
        if (c < 3) ret_load(R, Pb + (size_t)128 * NIN, tid, true);
        RET_BAR();
#define RET_ATILE(IT, JT) do { const int it_ = (IT), jt_ = (JT); f32x16 a_ = {}; \
            const LAS unsigned char* ap_ = L + RL_Q + (32 * it_ + r32) * 144 + hi * 16; const LAS unsigned char* bp_ = L + RL_K + (32 * jt_ + r32) * 144 + hi * 16; \
            _Pragma("unroll") for (int d0 = 0; d0 < 4; ++d0) a_ = __builtin_amdgcn_mfma_f32_32x32x16_bf16(rfrag(ap_ + d0 * 32), rfrag(bp_ + d0 * 32), a_, 0, 0, 0); \
            LAS unsigned short* am_ = (LAS unsigned short*)(L + RL_AM) + (32 * it_) * 136 + 32 * jt_ + r32; \
            _Pragma("unroll") for (int r = 0; r < 16; ++r) { const int il = crow16(r, hi); const float v_ = (jt_ < it_ || il >= r32) ? a_[r] : 0.f; am_[il * 136] = (unsigned short)f2bf(v_); } } while (0)
        if (w < 4) { const f32x16 kv = ret_kv_tile(F, dt, et); Sr = Sr * cd + kv * g127; RET_ATILE(w, w); }
        else if (w == 4) { RET_ATILE(1, 0); RET_ATILE(2, 0); }
        else if (w == 5) { RET_ATILE(2, 1); RET_ATILE(3, 0); }
        else if (w == 6) { RET_ATILE(3, 1); }
        else { RET_ATILE(3, 2); }
#undef RET_ATILE
        RET_BAR();
        {
            const int it = w >> 1; f32x16 o1 = {}, o2 = {};
            const LAS unsigned char* ap = L + RL_AM + (32 * it + r32) * 272 + hi * 16; const LAS unsigned char* bp = L + RL_VT + (32 * et + r32) * 272 + hi * 16;
            for (int jk = 0; jk < 2 * (it + 1); ++jk) o1 = __builtin_amdgcn_mfma_f32_32x32x16_bf16(rfrag(ap + jk * 32), rfrag(bp + jk * 32), o1, 0, 0, 0);
            const LAS unsigned char* qp = L + RL_Q + (32 * it + r32) * 144 + hi * 16; const LAS unsigned char* sp = L + RL_ST + (32 * et + r32) * 144 + hi * 16;
#pragma unroll
            for (int d0 = 0; d0 < 4; ++d0) o2 = __builtin_amdgcn_mfma_f32_32x32x16_bf16(rfrag(qp + d0 * 32), rfrag(sp + d0 * 32), o2, 0, 0, 0);
            LAS float* of = (LAS float*)(L + RL_OF) + (32 * it) * 68 + 32 * et + r32;
#pragma unroll
            for (int r = 0; r < 16; ++r) of[crow16(r, hi) * 68] = o1[r] + gam * o2[r];
        }
        RET_BAR();
        {
            const int eg = tid & 15, rq = tid >> 4;
#pragma unroll
            for (int rr = 0; rr < 4; ++rr) { const int row = 4 * rq + rr; const f32x4 o = *(const LAS f32x4*)((LAS float*)(L + RL_OF) + row * 68 + 4 * eg);
                float ss = (o[0] * o[0] + o[1] * o[1]) + (o[2] * o[2] + o[3] * o[3]);
                ss = sum16(ss);
                const float rn = rsqrtf(ss * (1.f / 64.f) + EPSN);
                const u32x2g gg = gcur[rr]; const float gt[4] = {bflo(gg.x), bfhi(gg.x), bflo(gg.y), bfhi(gg.y)}; float y[4];
#pragma unroll
                for (int e = 0; e < 4; ++e) y[e] = o[e] * rn * g4[e] * gt[e] * __builtin_amdgcn_rcpf(1.f + __builtin_amdgcn_exp2f(-1.4426950408889634f * gt[e]));
                u32x2 wv; wv.x = pk2(y[0], y[1]); wv.y = pk2(y[2], y[3]);
                *(GAS u32x2*)(F.MIX + (r0 + row) * 1024 + h * 64 + 4 * eg) = wv; }
        }
        if (w < 4) { LAS unsigned short* st = (LAS unsigned short*)(L + RL_ST) + (32 * et + r32) * 72 + 32 * dt;
#pragma unroll
            for (int r = 0; r < 16; ++r) st[crow16(r, hi)] = (unsigned short)f2bf(Sr[r]); }
        RET_BAR();
    }
}
__device__ __forceinline__ void difmix_rows(Frame& F) {
    const float la = wave_sum(F.lq1[F.lane] * F.lk1[F.lane]), lb = wave_sum(F.lq2[F.lane] * F.lk2[F.lane]);
    const float lam = __expf(la) - __expf(lb) + 0.2f;
    const int h = F.lane >> 4, e8 = (F.lane & 15) * 8;
    const f32x4 ga = *(const f32x4*)(F.gsub + e8), gb = *(const f32x4*)(F.gsub + e8 + 4);
    const int gw = F.vcu * NWAVES + F.wave, NGW = F.G * NWAVES;
    for (int row0 = gw; row0 < M; row0 += 4 * NGW) {
        int rows[4]; v4u o1[4], o2[4];
#pragma unroll
        for (int q = 0; q < 4; ++q) { rows[q] = (row0 + q * NGW < M) ? row0 + q * NGW : row0;
            o1[q] = *(const GAS v4u*)(F.O + (size_t)rows[q] * 1024 + h * 256 + e8); o2[q] = *(const GAS v4u*)(F.O + (size_t)rows[q] * 1024 + h * 256 + 128 + e8); }
#pragma unroll
        for (int q = 0; q < 4; ++q) {
            float d[8];
            d[0] = bflo(o1[q].x) - lam * bflo(o2[q].x); d[1] = bfhi(o1[q].x) - lam * bfhi(o2[q].x); d[2] = bflo(o1[q].y) - lam * bflo(o2[q].y); d[3] = bfhi(o1[q].y) - lam * bfhi(o2[q].y);
            d[4] = bflo(o1[q].z) - lam * bflo(o2[q].z); d[5] = bfhi(o1[q].z) - lam * bfhi(o2[q].z); d[6] = bflo(o1[q].w) - lam * bflo(o2[q].w); d[7] = bfhi(o1[q].w) - lam * bfhi(o2[q].w);
            float ss = 0.f;
#pragma unroll
            for (int i = 0; i < 8; ++i) ss += d[i] * d[i];
            ss = sum16(ss);
            const float r = rsqrtf(ss * (1.f / 128.f) + EPSN) * 0.8f;
            v4u w; w.x = pk2(d[0] * r * ga[0], d[1] * r * ga[1]); w.y = pk2(d[2] * r * ga[2], d[3] * r * ga[3]); w.z = pk2(d[4] * r * gb[0], d[5] * r * gb[1]); w.w = pk2(d[6] * r * gb[2], d[7] * r * gb[3]);
            *(GAS v4u*)(F.MIX + (size_t)rows[q] * 1024 + 512 + h * 128 + e8) = w;
        }
    }
}

__device__ __forceinline__ void attn_fallback(Frame& F) {
    LAS float* Ks = (LAS float*)(F.lds); LAS float* Vs = (LAS float*)(F.lds + 16384);
    const int tid = F.tid, qi = tid & 63, ec = tid >> 6;
    for (int it = F.vcu; it < 2048; it += F.G) {
        const int b = it >> 10, hm = (it >> 7) & 7, qb = it & 127;
        const bf16* Pq = F.P + ((size_t)b * T + qb * 64 + qi) * NIN + 2048 + hm * 64;
        float q[64], o[16], m = -INFINITY, l = 0.f;
#pragma unroll
        for (int c = 0; c < 8; ++c) { const v4u w = *(const GAS v4u*)(Pq + 8 * c); q[8 * c] = bflo(w.x); q[8 * c + 1] = bfhi(w.x); q[8 * c + 2] = bflo(w.y); q[8 * c + 3] = bfhi(w.y); q[8 * c + 4] = bflo(w.z); q[8 * c + 5] = bfhi(w.z); q[8 * c + 6] = bflo(w.w); q[8 * c + 7] = bfhi(w.w); }
#pragma unroll
        for (int i = 0; i < 16; ++i) o[i] = 0.f;
        for (int kt = 0; kt <= qb; ++kt) {
            const bf16* Pk = F.P + ((size_t)b * T + kt * 64) * NIN;
            { const int j = tid >> 3, c8 = tid & 7; const v4u w = *(const GAS v4u*)(Pk + (size_t)j * NIN + 2560 + hm * 64 + 8 * c8); LAS f32x4* kp = (LAS f32x4*)(Ks + j * 64 + 8 * c8);
              kp[0] = (f32x4){bflo(w.x), bfhi(w.x), bflo(w.y), bfhi(w.y)}; kp[1] = (f32x4){bflo(w.z), bfhi(w.z), bflo(w.w), bfhi(w.w)}; }
#pragma unroll
            for (int s2 = 0; s2 < 2; ++s2) { const int idx = tid + s2 * 512, j = idx >> 4, c16 = idx & 15; const v4u w = *(const GAS v4u*)(Pk + (size_t)j * NIN + 3072 + (hm >> 1) * 128 + 8 * c16); LAS f32x4* vp = (LAS f32x4*)(Vs + j * 128 + 8 * c16);
              vp[0] = (f32x4){bflo(w.x), bfhi(w.x), bflo(w.y), bfhi(w.y)}; vp[1] = (f32x4){bflo(w.z), bfhi(w.z), bflo(w.w), bfhi(w.w)}; }
            __syncthreads();
            const int jmax = (kt == qb) ? qi : 63;
            for (int j = 0; j < 64; ++j) {
                if (j <= jmax) {
                    float sc = 0.f;
#pragma unroll
                    for (int d = 0; d < 64; ++d) sc += q[d] * Ks[j * 64 + d];
                    const float mn = fmaxf(m, sc), corr = __builtin_amdgcn_exp2f(m - mn), p = __builtin_amdgcn_exp2f(sc - mn);
                    l = l * corr + p;
#pragma unroll
                    for (int i = 0; i < 16; ++i) o[i] = o[i] * corr + p * Vs[j * 128 + 16 * ec + i];
                    m = mn;
                }
            }
            __syncthreads();
        }
        const float rl = 1.f / l;
        v4u w0, w1; w0.x = pk2(o[0] * rl, o[1] * rl); w0.y = pk2(o[2] * rl, o[3] * rl); w0.z = pk2(o[4] * rl, o[5] * rl); w0.w = pk2(o[6] * rl, o[7] * rl);
        w1.x = pk2(o[8] * rl, o[9] * rl); w1.y = pk2(o[10] * rl, o[11] * rl); w1.z = pk2(o[12] * rl, o[13] * rl); w1.w = pk2(o[14] * rl, o[15] * rl);
        bf16* op = F.O + ((size_t)b * T + qb * 64 + qi) * 1024 + hm * 128 + 16 * ec;
        *(GAS v4u*)op = w0; *(GAS v4u*)(op + 8) = w1;
    }
}

struct Args { const float* in[16]; float* out; unsigned char* ws; int ph_lo, ph_hi; };
__global__ void __launch_bounds__(NWAVES * 64, 2) hy_fwd(Args args) {
    extern __shared__ __attribute__((aligned(16))) unsigned char lds[];
    Frame F;
    F.lds = (LAS unsigned char*)lds;
    F.MISC = (volatile LAS unsigned*)(F.lds + MISC_OFF);
    F.tid = threadIdx.x; F.lane = F.tid & 63; F.wave = __builtin_amdgcn_readfirstlane(F.tid >> 6);
    F.G = gridDim.x; { const int bx = blockIdx.x; F.vcu = (F.G % 8 == 0) ? (bx % 8) * (F.G / 8) + bx / 8 : bx; }
    unsigned char* ws = args.ws;
    F.ctl = (gu32*)(ws + WS_CTL);
    F.x = args.in[0]; F.g1 = args.in[1]; F.w_in = args.in[2]; F.retg = args.in[3]; F.gq = args.in[4]; F.gk = args.in[5]; F.lq1 = args.in[6]; F.lk1 = args.in[7];
    F.lq2 = args.in[8]; F.lk2 = args.in[9]; F.gsub = args.in[10]; F.w_out = args.in[11]; F.g2 = args.in[12]; F.w_gate = args.in[13]; F.w_up = args.in[14]; F.w_down = args.in[15];
    F.out = args.out;
    F.Win_t = (bf16*)(ws + WS_WIN); F.Wout_t = (bf16*)(ws + WS_WOUT); F.Wgu_t = (bf16*)(ws + WS_WGU); F.Wdn_t = (bf16*)(ws + WS_WDN);
    F.ropec = (float*)(ws + WS_ROPEC); F.ropes = (float*)(ws + WS_ROPES); F.rstd1 = (float*)(ws + WS_RSTD1); F.ss2 = (float*)(ws + WS_SS2); F.KV = (float*)(ws + WS_KV);
    F.XN = (bf16*)(ws + WS_XN); F.P = (bf16*)(ws + WS_P); F.HB = (bf16*)(ws + WS_H); F.O = (bf16*)(ws + WS_O); F.MIX = (bf16*)(ws + WS_MIX);
    for (int u = F.tid; u < (LDS_BYTES - LDSCTL_OFF) / 4; u += NWAVES * 64) ((LAS unsigned*)(F.lds + LDSCTL_OFF))[u] = 0u;
    __syncthreads();
    const int lo = args.ph_lo, hi = args.ph_hi;
    XcdBarrier bar; bar.bar = (unsigned*)(F.ctl + CW_BAR); bar.x = 0; bar.st = nullptr;
    if (hi - lo > 1) bar = xcd_barrier_post((unsigned*)(F.ctl + CW_BAR), F.MISC + 8);
#define IN(k) (lo <= (k) && (k) < hi)
#define BOTH(k) (IN(k) && IN((k) + 1))
#define GRID_BAR() xcd_barrier(bar)

    if (IN(0)) { p0_prologue(F); if (BOTH(0)) GRID_BAR(); }
    if (IN(1)) {
        pg8::Gemm g{F.XN, F.Win_t, M, NIN, D}; pg8::StaticOrder S; S.init(M, NIN, F.G, (int)blockIdx.x);
        LAS float* rs1 = (LAS float*)(F.lds + LDSCTL_OFF + 512);
        const int row0 = 2048 * ((int)blockIdx.x & 7);
        for (int r = F.tid; r < 2048; r += NWAVES * 64) rs1[r] = F.rstd1[row0 + r];
        __syncthreads();
        pg8::EpiIn E{F.P, F.rstd1, F.ropec, F.ropes, F.gq, F.gk, rs1, row0};
        pg8::gemm_phase<pg8::EpiIn, pg8::StaticOrder, true, true>(F.lds + RING_OFF, g, S, E);
        p0_deferred(F);
        if (BOTH(1)) GRID_BAR();
    }
    if (IN(2)) { for (int u = F.vcu; u < 256; u += F.G) ret_state_unit(F, u >> 4, u & 15); }
    if (IN(3)) {
        const attn_body::AttnTensors AT{(const attn_body::bf16*)F.P, (attn_body::bf16*)F.O};
        float gqm = fabsf(F.gq[F.lane]), gkm = fabsf(F.gk[F.lane]);
#pragma unroll
        for (int o = 1; o < 64; o <<= 1) { gqm = fmaxf(gqm, __shfl_xor(gqm, o)); gkm = fmaxf(gkm, __shfl_xor(gkm, o)); }
        const bool bounded = __builtin_amdgcn_readfirstlane((int)(64.f * attn_body::C2 * gqm * gkm < 100.f)) != 0;
        if (bounded) { const attn_body::StaticOrder2 S2((int)F.G, (int)blockIdx.x); attn_body::attn_phase2((char*)lds + RING_OFF, AT, S2); }
        else attn_fallback(F);
        if (BOTH(3)) GRID_BAR();
    }
    if (IN(4)) {
        { for (int u = F.vcu; u < 256; u += F.G) ret_unit(F, u >> 4, u & 15); }
        difmix_rows(F);
        if (BOTH(4)) GRID_BAR();
    }
    if (IN(5)) {
        pg8::Gemm g{F.MIX, F.Wout_t, M, D, D}; pg8::StaticOrder S; S.init(M, D, F.G, (int)blockIdx.x);
        pg8::EpiOut E{F.x, F.XN, F.ss2};
        pg8::gemm_phase<pg8::EpiOut, pg8::StaticOrder, true, true>(F.lds + RING_OFF, g, S, E);
        if (BOTH(5)) GRID_BAR();
    }
    if (IN(6)) {
        pg8::Gemm g{F.XN, F.Wgu_t, M, NGU, D}; pg8::StaticOrder S; S.init(M, NGU, F.G, (int)blockIdx.x);
        LAS float* rs2 = (LAS float*)(F.lds + LDSCTL_OFF + 512);
        const int row0 = 2048 * ((int)blockIdx.x & 7);
        for (int r = F.tid; r < 2048; r += NWAVES * 64) { const f32x4* sp = (const f32x4*)(F.ss2 + (size_t)(row0 + r) * 16); const f32x4 sa = sp[0] + sp[1] + sp[2] + sp[3];
            rs2[r] = rsqrtf(((sa[0] + sa[1]) + (sa[2] + sa[3])) * (1.f / 1024.f) + EPSN); }
        __syncthreads();
        pg8::EpiGU E{F.HB, F.ss2, rs2, row0};
        pg8::gemm_phase<pg8::EpiGU, pg8::StaticOrder, true, true>(F.lds + RING_OFF, g, S, E);
        if (BOTH(6)) GRID_BAR();
    }
    if (IN(7)) {
        pg8::Gemm g{F.HB, F.Wdn_t, M, D, FF}; pg8::StaticOrder S; S.init(M, D, F.G, (int)blockIdx.x);
        pg8::EpiDown E{F.XN, F.out};
        pg8::gemm_phase<pg8::EpiDown, pg8::StaticOrder, true, true>(F.lds + RING_OFF, g, S, E);
    }
#undef IN
#undef BOTH
#undef GRID_BAR
}

extern "C" void kernel_launch(void* const* d_in, const int* in_sizes, int n_in, void* d_out, int out_size, void* d_ws, size_t ws_size, hipStream_t stream) {
    static int grid = 0;
    if (grid == 0) {
        if (n_in != 16 || in_sizes[0] != M * D || out_size != M * D || ws_size < WS_END) { fprintf(stderr, "kernel_launch: unexpected shapes (n_in %d, in0 %d, out %d, ws %zu); nothing launched\n", n_in, n_in > 0 ? in_sizes[0] : -1, out_size, ws_size); grid = -1; return; }
        int dev = 0, cus = 0, per_cu = 0;
        if (hipGetDevice(&dev) != hipSuccess || hipDeviceGetAttribute(&cus, hipDeviceAttributeMultiprocessorCount, dev) != hipSuccess) { grid = -1; return; }
        if (hipFuncSetAttribute((const void*)hy_fwd, hipFuncAttributeMaxDynamicSharedMemorySize, LDS_BYTES) != hipSuccess) { fprintf(stderr, "kernel_launch: hipFuncSetAttribute failed\n"); grid = -1; return; }
        if (hipOccupancyMaxActiveBlocksPerMultiprocessor(&per_cu, (const void*)hy_fwd, NWAVES * 64, LDS_BYTES) != hipSuccess || per_cu < 1) fprintf(stderr, "kernel_launch: note: occupancy query reports %d workgroups per CU\n", per_cu);
        (void)hipGetLastError();
        grid = cus;
        if (grid != 256) fprintf(stderr, "kernel_launch: %d CUs; the phase programs assume 256\n", grid);
    }
    if (grid < 0) return;
    if (hipMemsetAsync((char*)d_ws + WS_CTL, 0, CTL_ZERO_BYTES, stream) != hipSuccess) return;
    Args a{};
    for (int i = 0; i < 16; ++i) a.in[i] = (const float*)d_in[i];
    a.out = (float*)d_out; a.ws = (unsigned char*)d_ws;
    a.ph_lo = 0; a.ph_hi = PER_PHASE;
    hipLaunchKernelGGL(hy_fwd, dim3(grid), dim3(NWAVES * 64), LDS_BYTES, stream, a);
}
```

```cpp
#include <hip/hip_runtime.h>
#include <cstdio>
#include <cstdint>

namespace pg8 {
#define PG8_LAS __attribute__((address_space(3)))
typedef unsigned short bf16_t;
typedef short bf16x8 __attribute__((ext_vector_type(8)));
typedef float f32x4 __attribute__((ext_vector_type(4)));
typedef unsigned u32x4 __attribute__((ext_vector_type(4)));
constexpr int BM = 256, BK = 64, HALF = 128, HTB = HALF * BK * 2  , STAGE_BYTES = 8 * HTB, NXCD = 8, WGM = 8;

__host__ __device__ __forceinline__ int lds_byte(int r, int c) { const int st = (r >> 4) * 2 + (c >> 5), rr = r & 15, cc = c & 31, ob = rr * 64 + cc * 2; return st * 1024 + (ob ^ (((ob >> 9) & 1) << 5)); }
__host__ __device__ __forceinline__ void stage_rc(int b, int& R, int& C) { const int st = b / 1024, sb = b % 1024, swz = sb ^ (((sb >> 9) & 1) << 5); R = (st >> 1) * 16 + swz / 64; C = (st & 1) * 32 + (swz % 64) / 2; }
__host__ __device__ __forceinline__ int perm32(int rho) { const int n = rho >> 4, i = rho & 15; return 8 * (i >> 2) + 4 * n + (i & 3); }

struct Unit { int pm, pn; };
struct Gemm { const bf16_t* A; const bf16_t* Bt; int M, N, K; };

struct StaticOrder {
    int nM, nN, nwg, G, c;
    __host__ __device__ void init(int M, int N, int G_, int c_) { nM = M / BM; nN = N / BM; nwg = nM * nN; G = G_; c = c_; }
    __host__ __device__ bool next(int i, Unit& u) const {
        const long L = (long)i * G + c; if (L >= nwg) return false;
        int wgid = (int)L; { const int q = nwg / NXCD, r = nwg % NXCD, xcd = wgid % NXCD, off = wgid / NXCD; wgid = (xcd < r ? xcd * (q + 1) : r * (q + 1) + (xcd - r) * q) + off; }
        const int nig = WGM * nN, gid = wgid / nig, fm = gid * WGM, gsz = (nM - fm) < WGM ? (nM - fm) : WGM;
        u.pm = fm + ((wgid % nig) % gsz); u.pn = (wgid % nig) / gsz; return true;
    }
    __device__ __forceinline__ void a_ready(const Unit&) const {}
    __device__ __forceinline__ void done(const Unit&) const {}
};

typedef float f32x2_cvp __attribute__((ext_vector_type(2))); typedef __bf16 bf16x2_cvp __attribute__((ext_vector_type(2)));
__device__ __forceinline__ unsigned cvt_pk_bf16(float lo, float hi) { const f32x2_cvp v = {lo, hi}; return __builtin_bit_cast(unsigned, __builtin_convertvector(v, bf16x2_cvp)); }
typedef float f32x2 __attribute__((ext_vector_type(2)));
__device__ __forceinline__ float sum_rows4(float v) {
    const auto a = __builtin_amdgcn_permlane16_swap(__float_as_uint(v), __float_as_uint(v), false, false); v = __uint_as_float(a[0]) + __uint_as_float(a[1]);
    const auto b = __builtin_amdgcn_permlane32_swap(__float_as_uint(v), __float_as_uint(v), false, false); return __uint_as_float(b[0]) + __uint_as_float(b[1]);
}
constexpr float EPS_N = 1e-6f, QC2 = 0.125f * 1.4426950408889634f;
struct EpiIn {
    static constexpr bool PERM = true, AFTER_DRAIN = false;
    bf16_t* P; const float* rstd1; const float* ropec; const float* ropes; const float* gq; const float* gk; const PG8_LAS float* rs1; int row0;
    __device__ __forceinline__ void operator()(const f32x4 (&acc)[2][2][4][2], const Unit& u, int wr, int wc, int fr, int fq) const {
        const int pn = u.pn;
        const int kind = (pn < 4) ? 1 : ((pn >= 8 && pn < 12) ? 2 : 0);
        const float sc = (kind == 1) ? ((pn >= 2) ? 0.125f : 1.f) : ((kind == 2 && pn < 10) ? QC2 : 1.f);
        const int colb = pn * BM + 64 * wc + 8 * fq;
        f32x4 g[2][2];
#pragma unroll
        for (int bj = 0; bj < 2; ++bj)
#pragma unroll
            for (int n = 0; n < 2; ++n) g[bj][n] = (kind == 2) ? *(const f32x4*)(((pn < 10) ? gq : gk) + 32 * bj + 8 * fq + 4 * n) : (f32x4){1.f, 1.f, 1.f, 1.f};
#pragma unroll
        for (int ai = 0; ai < 2; ++ai)
#pragma unroll
            for (int m = 0; m < 4; ++m) {
                const int row = u.pm * BM + ai * HALF + wr * 64 + m * 16 + fr;
                const float rs = ((unsigned)(row - row0) < 2048u) ? rs1[row - row0] : rstd1[row];
                f32x4 v[2][2];
#pragma unroll
                for (int bj = 0; bj < 2; ++bj)
#pragma unroll
                    for (int n = 0; n < 2; ++n) v[bj][n] = acc[ai][bj][m][n] * rs;
                if (kind == 1) {
                    const int pos = row & 8191;
#pragma unroll
                    for (int n = 0; n < 2; ++n) { const f32x4 c4 = *(const f32x4*)(ropec + pos * 32 + 8 * fq + 4 * n), s4 = *(const f32x4*)(ropes + pos * 32 + 8 * fq + 4 * n);
                        const f32x4 a = v[0][n], b = v[1][n]; v[0][n] = (a * c4 - b * s4) * sc; v[1][n] = (a * s4 + b * c4) * sc; }
                } else if (kind == 2) {
                    float ss = 0.f;
#pragma unroll
                    for (int bj = 0; bj < 2; ++bj)
#pragma unroll
                        for (int n = 0; n < 2; ++n) { const f32x4 t = v[bj][n]; ss += (t[0] * t[0] + t[1] * t[1]) + (t[2] * t[2] + t[3] * t[3]); }
                    ss = sum_rows4(ss);
                    const float r = rsqrtf(ss * (1.f / 64.f) + EPS_N) * sc;
#pragma unroll
                    for (int bj = 0; bj < 2; ++bj)
#pragma unroll
                        for (int n = 0; n < 2; ++n) v[bj][n] = v[bj][n] * r * g[bj][n];
                }
                bf16_t* rowp = P + (size_t)row * 3584 + colb;
#pragma unroll
                for (int bj = 0; bj < 2; ++bj) { u32x4 w; w.x = cvt_pk_bf16(v[bj][0][0], v[bj][0][1]); w.y = cvt_pk_bf16(v[bj][0][2], v[bj][0][3]); w.z = cvt_pk_bf16(v[bj][1][0], v[bj][1][1]); w.w = cvt_pk_bf16(v[bj][1][2], v[bj][1][3]);
                    *(u32x4*)(rowp + 32 * bj) = w; }
            }
    }
};
struct EpiOut {
    static constexpr bool PERM = true, AFTER_DRAIN = false;
    const float* x; bf16_t* xn; float* ss2;
    __device__ __forceinline__ void operator()(const f32x4 (&acc)[2][2][4][2], const Unit& u, int wr, int wc, int fr, int fq) const {
        const int colb = u.pn * BM + 32 * wc + 8 * fq;
#pragma unroll
        for (int ai = 0; ai < 2; ++ai)
#pragma unroll
            for (int m = 0; m < 4; ++m) {
                const int row = u.pm * BM + ai * HALF + wr * 64 + m * 16 + fr; const size_t off = (size_t)row * 1024 + colb; float ss = 0.f;
#pragma unroll
                for (int bj = 0; bj < 2; ++bj) { const f32x4 v0 = __builtin_nontemporal_load((const f32x4*)(x + off + HALF * bj)) + acc[ai][bj][m][0], v1 = __builtin_nontemporal_load((const f32x4*)(x + off + HALF * bj + 4)) + acc[ai][bj][m][1];
                    ss += (v0[0] * v0[0] + v0[1] * v0[1]) + (v0[2] * v0[2] + v0[3] * v0[3]) + (v1[0] * v1[0] + v1[1] * v1[1]) + (v1[2] * v1[2] + v1[3] * v1[3]);
                    u32x4 w; w.x = cvt_pk_bf16(v0[0], v0[1]); w.y = cvt_pk_bf16(v0[2], v0[3]); w.z = cvt_pk_bf16(v1[0], v1[1]); w.w = cvt_pk_bf16(v1[2], v1[3]);
                    *(u32x4*)(xn + off + HALF * bj) = w; }
                ss = sum_rows4(ss);
                if (fq == 0) ss2[(size_t)row * 16 + u.pn * 4 + wc] = ss;
            }
    }
};
struct EpiGU {
    static constexpr bool PERM = true, AFTER_DRAIN = false;
    bf16_t* H; const float* ss2; const PG8_LAS float* rs2; int row0;
    __device__ __forceinline__ void operator()(const f32x4 (&acc)[2][2][4][2], const Unit& u, int wr, int wc, int fr, int fq) const {
        const int colb = u.pn * HALF + 32 * wc + 8 * fq;
#pragma unroll
        for (int ai = 0; ai < 2; ++ai)
#pragma unroll
            for (int m = 0; m < 4; ++m) {
                const int row = u.pm * BM + ai * HALF + wr * 64 + m * 16 + fr;
                float rs;
                if ((unsigned)(u.pm * BM - row0) < 2048u) rs = rs2[row - row0];
                else { const f32x4* sp = (const f32x4*)(ss2 + (size_t)row * 16); const f32x4 sa = sp[0] + sp[1] + sp[2] + sp[3]; rs = rsqrtf(((sa[0] + sa[1]) + (sa[2] + sa[3])) * (1.f / 1024.f) + EPS_N); }
                f32x4 hv[2];
#pragma unroll
                for (int n = 0; n < 2; ++n) { const f32x4 gt = acc[ai][0][m][n] * rs, up = acc[ai][1][m][n] * rs;
#pragma unroll
                    for (int e = 0; e < 4; ++e) hv[n][e] = gt[e] * __builtin_amdgcn_rcpf(1.f + __builtin_amdgcn_exp2f(-1.4426950408889634f * gt[e])) * up[e]; }
                u32x4 w; w.x = cvt_pk_bf16(hv[0][0], hv[0][1]); w.y = cvt_pk_bf16(hv[0][2], hv[0][3]); w.z = cvt_pk_bf16(hv[1][0], hv[1][1]); w.w = cvt_pk_bf16(hv[1][2], hv[1][3]);
                *(u32x4*)(H + (size_t)row * 2816 + colb) = w;
            }
    }
};
struct EpiDown {
    static constexpr bool PERM = true, AFTER_DRAIN = false;
    const bf16_t* xn; float* out;
    __device__ __forceinline__ void operator()(const f32x4 (&acc)[2][2][4][2], const Unit& u, int wr, int wc, int fr, int fq) const {
        const int colb = u.pn * BM + 32 * wc + 8 * fq;
#pragma unroll
        for (int ai = 0; ai < 2; ++ai)
#pragma unroll
            for (int m = 0; m < 4; ++m) {
                const size_t off = (size_t)(u.pm * BM + ai * HALF + wr * 64 + m * 16 + fr) * 1024 + colb;
#pragma unroll
                for (int bj = 0; bj < 2; ++bj) { const u32x4 w = *(const u32x4*)(xn + off + HALF * bj);
                    const f32x4 r0 = {__uint_as_float(w.x << 16), __uint_as_float(w.x & 0xffff0000u), __uint_as_float(w.y << 16), __uint_as_float(w.y & 0xffff0000u)};
                    const f32x4 r1 = {__uint_as_float(w.z << 16), __uint_as_float(w.z & 0xffff0000u), __uint_as_float(w.w << 16), __uint_as_float(w.w & 0xffff0000u)};
                    __builtin_nontemporal_store(r0 + acc[ai][bj][m][0], (f32x4*)(out + off + HALF * bj)); __builtin_nontemporal_store(r1 + acc[ai][bj][m][1], (f32x4*)(out + off + HALF * bj + 4)); }
            }
    }
};
template <class Epi, class Sched, bool ALIGN_EPI = false, bool SP2 = false>
__device__ __forceinline__ void gemm_phase(PG8_LAS unsigned char* lds, const Gemm g, const Sched& S, const Epi& E) {
    const int tid = threadIdx.x, wid = __builtin_amdgcn_readfirstlane(tid >> 6), lane = tid & 63, wr = wid >> 2, wc = wid & 3, fr = lane & 15, fq = lane >> 4;
    const int K = g.K, nt = K / BK;
    unsigned voffA[2], voffB[2];
#pragma unroll
    for (int i = 0; i < 2; ++i) { int R, C; stage_rc(tid * 16 + i * 8192, R, C); const int Rb = Epi::PERM ? ((R & ~31) + perm32(R & 31)) : R;
        voffA[i] = (unsigned)(R * K + C) * 2u; voffB[i] = (unsigned)(Rb * K + C) * 2u; }
    const size_t kstep = (size_t)(BK * 2);
    const size_t hstep = (size_t)HALF * K * 2;
    const size_t tstep = 2 * hstep;
    const unsigned ldsw = (unsigned)wid * 1024u;
    const int aoff = lds_byte(wr * 64 + fr, fq * 8), boff = lds_byte(wc * 32 + fr, fq * 8);
#define PG8_SA(b, h) (((b) * 2 + (h)) * HTB)
#define PG8_SB(b, h) ((4 + (b) * 2 + (h)) * HTB)
#define PG8_STAGE(bufoff, gbase, voff) do { _Pragma("unroll") for (int _i = 0; _i < 2; ++_i) \
        __builtin_amdgcn_global_load_lds((const unsigned*)((const char*)(gbase) + (voff)[_i]), (PG8_LAS unsigned*)(lds + (bufoff) + ldsw + _i * 8192), 16, 0, 0); } while (0)
#define PG8_LDA(dst, b, h) do { _Pragma("unroll") for (int m = 0; m < 4; ++m) _Pragma("unroll") for (int k = 0; k < 2; ++k) dst[m][k] = *(const PG8_LAS bf16x8*)(lds + PG8_SA(b, h) + aoff + m * 2048 + k * 1024); } while (0)
#define PG8_LDB(dst, b, h) do { _Pragma("unroll") for (int n = 0; n < 2; ++n) _Pragma("unroll") for (int k = 0; k < 2; ++k) dst[n][k] = *(const PG8_LAS bf16x8*)(lds + PG8_SB(b, h) + boff + n * 2048 + k * 1024); } while (0)
#define PG8_MMA(ai, bj, At, Bt) do { __builtin_amdgcn_s_setprio(1); _Pragma("unroll") for (int m = 0; m < 4; ++m) _Pragma("unroll") for (int n = 0; n < 2; ++n) _Pragma("unroll") for (int k = 0; k < 2; ++k) \
        acc[ai][bj][m][n] = __builtin_amdgcn_mfma_f32_16x16x32_bf16(Bt[n][k], At[m][k], acc[ai][bj][m][n], 0, 0, 0); __builtin_amdgcn_s_setprio(0); } while (0)
#define PG8_WAIT_V(n) asm volatile("s_waitcnt vmcnt(" #n ")" ::: "memory")
#define PG8_WAIT_L(n) asm volatile("s_waitcnt lgkmcnt(" #n ")" ::: "memory")
#define PG8_BAR __builtin_amdgcn_s_barrier()
#define PG8_SCHED __builtin_amdgcn_sched_barrier(0)
    Unit cur, nxt; int ui = 0;
    if (!S.next(0, cur)) return;
    f32x4 acc[2][2][4][2];
#pragma unroll
    for (int a = 0; a < 2; ++a)
#pragma unroll
        for (int b = 0; b < 2; ++b)
#pragma unroll
            for (int m = 0; m < 4; ++m)
#pragma unroll
                for (int n = 0; n < 2; ++n) acc[a][b][m][n] = (f32x4){0.f, 0.f, 0.f, 0.f};
    bf16x8 At[4][2], B0[2][2], B1[2][2];
    const char* cA = (const char*)g.A + (size_t)cur.pm * tstep; const char* cB = (const char*)g.Bt + (size_t)cur.pn * tstep;
    S.a_ready(cur);
    if constexpr (SP2) {
        PG8_STAGE(PG8_SB(0, 0), cB, voffB); PG8_STAGE(PG8_SB(0, 1), cB + hstep, voffB); PG8_STAGE(PG8_SA(0, 0), cA, voffA); PG8_STAGE(PG8_SA(0, 1), cA + hstep, voffA);
        if (wr == 1) PG8_BAR;
        PG8_WAIT_V(2); PG8_BAR;
        PG8_STAGE(PG8_SB(1, 0), cB + kstep, voffB); PG8_STAGE(PG8_SA(1, 0), cA + kstep, voffA); PG8_STAGE(PG8_SB(1, 1), cB + hstep + kstep, voffB);
        PG8_WAIT_V(6); PG8_BAR;
    } else {
        PG8_STAGE(PG8_SB(0, 0), cB, voffB); PG8_STAGE(PG8_SA(0, 0), cA, voffA); PG8_STAGE(PG8_SB(0, 1), cB + hstep, voffB); PG8_STAGE(PG8_SA(0, 1), cA + hstep, voffA);
        if (wr == 1) PG8_BAR;
        PG8_WAIT_V(4); PG8_BAR;
        PG8_STAGE(PG8_SB(1, 0), cB + kstep, voffB); PG8_STAGE(PG8_SA(1, 0), cA + kstep, voffA); PG8_STAGE(PG8_SB(1, 1), cB + hstep + kstep, voffB);
        PG8_WAIT_V(6); PG8_BAR;
    }
    for (;;) {
        const bool has_next = S.next(ui + 1, nxt);
        const char* nA = has_next ? (const char*)g.A + (size_t)nxt.pm * tstep : cA; const char* nB = has_next ? (const char*)g.Bt + (size_t)nxt.pn * tstep : cB;
        for (int t = 0; t < nt; t += 2) {
            const bool last = (t == nt - 2);
            const char* a1 = cA + (size_t)(t + 1) * kstep;
            const char* a2 = last ? nA : cA + (size_t)(t + 2) * kstep; const char* b2 = last ? nB : cB + (size_t)(t + 2) * kstep;
            const char* a3 = a2 + kstep; const char* b3 = b2 + kstep;
            if (last && has_next) S.a_ready(nxt);
            if constexpr (SP2) {
            PG8_LDB(B0, 0, 0); PG8_LDB(B1, 0, 1); PG8_SCHED; PG8_LDA(At, 0, 0); PG8_STAGE(PG8_SA(1, 1), a1 + hstep, voffA);
            PG8_WAIT_V(8); PG8_WAIT_L(0); PG8_BAR; PG8_MMA(0, 0, At, B0); PG8_MMA(0, 1, At, B1); PG8_BAR; PG8_SCHED;
            PG8_LDA(At, 0, 1); PG8_STAGE(PG8_SB(0, 0), b2, voffB); PG8_STAGE(PG8_SB(0, 1), b2 + hstep, voffB); PG8_STAGE(PG8_SA(0, 0), a2, voffA);
            PG8_WAIT_V(8); PG8_WAIT_L(0); PG8_BAR; PG8_MMA(1, 0, At, B0); PG8_MMA(1, 1, At, B1); PG8_BAR; PG8_SCHED;
            PG8_LDB(B0, 1, 0); PG8_LDB(B1, 1, 1); PG8_SCHED; PG8_LDA(At, 1, 0); PG8_STAGE(PG8_SA(0, 1), a2 + hstep, voffA);
            PG8_WAIT_V(8); PG8_WAIT_L(0); PG8_BAR; PG8_MMA(0, 0, At, B0); PG8_MMA(0, 1, At, B1); PG8_BAR; PG8_SCHED;
            PG8_LDA(At, 1, 1); PG8_STAGE(PG8_SB(1, 0), b3, voffB); PG8_STAGE(PG8_SB(1, 1), b3 + hstep, voffB); PG8_STAGE(PG8_SA(1, 0), a3, voffA);
            PG8_WAIT_V(8); PG8_WAIT_L(0); PG8_BAR; PG8_MMA(1, 0, At, B0); PG8_MMA(1, 1, At, B1); PG8_BAR; PG8_SCHED;
            } else {
            PG8_LDB(B0, 0, 0); PG8_SCHED; PG8_LDA(At, 0, 0); PG8_STAGE(PG8_SA(1, 1), a1 + hstep, voffA);
            PG8_WAIT_L(8); PG8_BAR; PG8_WAIT_L(0); PG8_MMA(0, 0, At, B0); PG8_BAR; PG8_SCHED;
            PG8_LDB(B1, 0, 1); PG8_STAGE(PG8_SB(0, 0), b2, voffB);
            PG8_BAR; PG8_WAIT_L(0); PG8_MMA(0, 1, At, B1); PG8_BAR;
            PG8_LDA(At, 0, 1); PG8_STAGE(PG8_SA(0, 0), a2, voffA);
            PG8_BAR; PG8_WAIT_L(0); PG8_MMA(1, 0, At, B0); PG8_BAR; PG8_SCHED;
            PG8_STAGE(PG8_SB(0, 1), b2 + hstep, voffB);
            PG8_WAIT_V(6); PG8_BAR; PG8_MMA(1, 1, At, B1); PG8_BAR;
            PG8_LDB(B0, 1, 0); PG8_SCHED; PG8_LDA(At, 1, 0); PG8_STAGE(PG8_SA(0, 1), a2 + hstep, voffA);
            PG8_WAIT_L(8); PG8_BAR; PG8_WAIT_L(0); PG8_MMA(0, 0, At, B0); PG8_BAR; PG8_SCHED;
            PG8_LDB(B1, 1, 1); PG8_STAGE(PG8_SB(1, 0), b3, voffB);
            PG8_BAR; PG8_WAIT_L(0); PG8_MMA(0, 1, At, B1); PG8_BAR;
            PG8_LDA(At, 1, 1); PG8_STAGE(PG8_SA(1, 0), a3, voffA);
            PG8_BAR; PG8_WAIT_L(0); PG8_MMA(1, 0, At, B0); PG8_BAR; PG8_SCHED;
            PG8_STAGE(PG8_SB(1, 1), b3 + hstep, voffB);
            PG8_WAIT_V(6); PG8_BAR; PG8_MMA(1, 1, At, B1); PG8_BAR;
            }
        }
        if constexpr (ALIGN_EPI) { if (wr == 0) PG8_BAR; }
        if constexpr (!Epi::AFTER_DRAIN) { E(acc, cur, wr, wc, fr, fq); S.done(cur); }
        if (!has_next) break;
#pragma unroll
        for (int a = 0; a < 2; ++a)
#pragma unroll
            for (int b = 0; b < 2; ++b)
#pragma unroll
                for (int m = 0; m < 4; ++m)
#pragma unroll
                    for (int n = 0; n < 2; ++n) acc[a][b][m][n] = (f32x4){0.f, 0.f, 0.f, 0.f};
        cur = nxt; cA = nA; cB = nB; ++ui;
        if constexpr (ALIGN_EPI) { if (wr == 1) PG8_BAR; }
    }
    PG8_WAIT_V(0);
    if constexpr (!ALIGN_EPI) { if (wr == 0) PG8_BAR; }
    PG8_BAR;
    if constexpr (Epi::AFTER_DRAIN) { E.fused(acc, cur, wr, wc, fr, fq, lds, wid, lane); S.done(cur); }
#undef PG8_SA
#undef PG8_SB
#undef PG8_STAGE
#undef PG8_LDA
#undef PG8_LDB
#undef PG8_MMA
#undef PG8_WAIT_V
#undef PG8_WAIT_L
#undef PG8_BAR
#undef PG8_SCHED
}
}

#ifndef PG8_SP2
#define PG8_SP2 true
#endif
#ifndef PG8_ALIGN
#define PG8_ALIGN true
#endif
#include <hip/hip_bf16.h>
#include <cmath>
namespace attn_body {
using bf16=__hip_bfloat16;
using bf16x8=__attribute__((ext_vector_type(8)))short;
using s16x4=__attribute__((ext_vector_type(4)))short;
using f32x16=__attribute__((ext_vector_type(16)))float;
using u32x4=__attribute__((ext_vector_type(4)))unsigned;
constexpr int BATCH=2,NHEAD=16,SEQ=8192,D=64,PQ=3584,PO=1024;
constexpr int NW=8,QBLK=32,QB=QBLK*NW,KVBLK=64,NQB=SEQ/QB;
constexpr int ATTN_UNIT_ROWS=QB;
__device__ __forceinline__ int crow(int r,int hi){return (r&3)+8*(r>>2)+4*hi;}
#define SBAR() __builtin_amdgcn_sched_barrier(0)
__device__ __forceinline__ void cmask(f32x16&p0,f32x16&p1,int jb,int qrel,int hi){
  const float NEG=-INFINITY; int kb=64*jb+4*hi;
  #pragma unroll
  for(int r=0;r<16;++r){int kv=kb+(r&3)+8*(r>>2); if(kv>qrel)p0[r]=NEG; if(kv+32>qrel)p1[r]=NEG;}
}

constexpr int NSLOT=3, SLOTB=8192;
constexpr int LDS_K=0, LDS_V=NSLOT*SLOTB, LDS_WS=2*NSLOT*SLOTB, LDS_OST=LDS_WS+NW*64*4, LDS_BYTES=LDS_OST+NW*4096;
constexpr float C2=0.125f*1.4426950408889634f;
__device__ __forceinline__ void glds16(const void*gsrc,unsigned lds_dst){unsigned keep;
  asm volatile("s_mov_b32 %0, m0\n\ts_mov_b32 m0, %2\n\ts_nop 0\n\tglobal_load_lds_dwordx4 %1, off\n\ts_mov_b32 m0, %0":"=&s"(keep):"v"(gsrc),"s"(lds_dst):"memory");}
__device__ __forceinline__ float max3f(float a,float b,float c){float r;asm("v_max3_f32 %0, %1, %2, %3":"=v"(r):"v"(a),"v"(b),"v"(c));return r;}
__device__ __forceinline__ float max2f(float a,float b){float r;asm("v_max_f32_e32 %0, %1, %2":"=v"(r):"v"(a),"v"(b));return r;}
__device__ __forceinline__ float fadd_s(float a,float b){float r;asm("v_add_f32_e32 %0, %1, %2":"=v"(r):"v"(a),"v"(b));return r;}
__device__ __forceinline__ float fsub_s(float a,float b){float r;asm("v_sub_f32_e32 %0, %1, %2":"=v"(r):"v"(a),"v"(b));return r;}
typedef float f32x2_t __attribute__((ext_vector_type(2))); typedef __bf16 bf16x2_t __attribute__((ext_vector_type(2)));
__device__ __forceinline__ unsigned cvtpk_s(float lo,float hi){f32x2_t v={lo,hi};bf16x2_t b=__builtin_convertvector(v,bf16x2_t);return __builtin_bit_cast(unsigned,b);}
#define WAIT_BAR(N) asm volatile("s_waitcnt vmcnt(" #N ") lgkmcnt(0)\n\ts_barrier":::"memory")

__device__ __forceinline__ void qkt(f32x16&p0,f32x16&p1,const char*Kslot,const bf16x8*qr,const f32x16&negm,int r32,int hi){
  const char*kb=Kslot+hi*1024+r32*16;
  #pragma unroll
  for(int d0=0;d0<4;++d0){
    const bf16x8 b0=*reinterpret_cast<const bf16x8*>(kb+d0*2048);
    const bf16x8 b1=*reinterpret_cast<const bf16x8*>(kb+d0*2048+512);
    if(d0==0){p0=__builtin_amdgcn_mfma_f32_32x32x16_bf16(b0,qr[0],negm,0,0,0);p1=__builtin_amdgcn_mfma_f32_32x32x16_bf16(b1,qr[0],negm,0,0,0);}
    else{p0=__builtin_amdgcn_mfma_f32_32x32x16_bf16(b0,qr[d0],p0,0,0,0);p1=__builtin_amdgcn_mfma_f32_32x32x16_bf16(b1,qr[d0],p1,0,0,0);}}
}
typedef __attribute__((address_space(3))) const char* lds_cptr;
typedef short v4i16_t __attribute__((ext_vector_type(4)));
__device__ __forceinline__ void kload8(bf16x8*kf,lds_cptr kp){
  kf[0]=*(const __attribute__((address_space(3))) bf16x8*)(kp);      kf[1]=*(const __attribute__((address_space(3))) bf16x8*)(kp+512);
  kf[2]=*(const __attribute__((address_space(3))) bf16x8*)(kp+2048); kf[3]=*(const __attribute__((address_space(3))) bf16x8*)(kp+2560);
  kf[4]=*(const __attribute__((address_space(3))) bf16x8*)(kp+4096); kf[5]=*(const __attribute__((address_space(3))) bf16x8*)(kp+4608);
  kf[6]=*(const __attribute__((address_space(3))) bf16x8*)(kp+6144); kf[7]=*(const __attribute__((address_space(3))) bf16x8*)(kp+6656);
}
__device__ __forceinline__ void kload2(bf16x8*kf,lds_cptr kp,int j){ kf[2*j]=*(const __attribute__((address_space(3))) bf16x8*)(kp+j*2048); kf[2*j+1]=*(const __attribute__((address_space(3))) bf16x8*)(kp+j*2048+512); }
__device__ __forceinline__ s16x4 vtr(lds_cptr p){ return __builtin_bit_cast(s16x4,__builtin_amdgcn_ds_read_tr16_b64_v4i16((__attribute__((address_space(3))) v4i16_t*)p)); }
__device__ __forceinline__ float rowmax(const f32x16&p0,const f32x16&p1){
  float a=max3f(p0[0],p0[1],p1[0]),b=max3f(p0[2],p0[3],p1[1]);a=max3f(a,p1[2],p1[3]);
  #pragma unroll
  for(int r=4;r<16;r+=4){a=max3f(a,p0[r],p0[r+1]);b=max3f(b,p0[r+2],p0[r+3]);a=max3f(a,p1[r],p1[r+1]);b=max3f(b,p1[r+2],p1[r+3]);}
  const float m=max2f(a,b);
  auto rr=__builtin_amdgcn_permlane32_swap(__float_as_uint(m),__float_as_uint(m),false,false);
  return max2f(__uint_as_float(rr[0]),__uint_as_float(rr[1]));
}
__device__ __forceinline__ void pv(f32x16*o,int vb,bf16x8 pa0,bf16x8 pa1,bf16x8 pa2,bf16x8 pa3){
  #pragma unroll
  for(int d0=0;d0<2;++d0){s16x4 lo[4],hi[4];
    #pragma unroll
    for(int ks=0;ks<4;++ks){
      asm volatile("ds_read_b64_tr_b16 %0,%1 offset:%c2":"=&v"(lo[ks]):"v"(vb),"i"(d0*4096+ks*1024):"memory");
      asm volatile("ds_read_b64_tr_b16 %0,%1 offset:%c2":"=&v"(hi[ks]):"v"(vb),"i"(d0*4096+ks*1024+512):"memory");}
    asm volatile("s_waitcnt lgkmcnt(0)":::"memory");SBAR();
    #define PK(k) (bf16x8){lo[k][0],lo[k][1],lo[k][2],lo[k][3],hi[k][0],hi[k][1],hi[k][2],hi[k][3]}
    o[d0]=__builtin_amdgcn_mfma_f32_32x32x16_bf16(pa0,PK(0),o[d0],0,0,0);
    o[d0]=__builtin_amdgcn_mfma_f32_32x32x16_bf16(pa1,PK(1),o[d0],0,0,0);
    o[d0]=__builtin_amdgcn_mfma_f32_32x32x16_bf16(pa2,PK(2),o[d0],0,0,0);
    o[d0]=__builtin_amdgcn_mfma_f32_32x32x16_bf16(pa3,PK(3),o[d0],0,0,0);
    #undef PK
  }
}

#ifndef ATTN_STORE16
#define ATTN_STORE16(p,v) (*(u32x4*)(p)=(v))
#endif
constexpr int ATTN_LDS_BYTES=LDS_BYTES;
struct AttnTensors { const bf16* P; bf16* O; };
struct AttnUnit { int bh; int qb; };
constexpr int L2_K=0, L2_V=NSLOT*SLOTB, L2_WS=L2_V+NSLOT*2*SLOTB, L2_OST=L2_WS+NW*64*4, L2_BYTES=L2_OST+NW*4096;
__device__ __forceinline__ void attn_unit2(int b,int qb,const bf16*Q,const bf16*__restrict__ K,const bf16*__restrict__ V,bf16*O,char*shm){
  const int tid=threadIdx.x,lane=tid&63,r32=lane&31,hi=lane>>5; const int wid=__builtin_amdgcn_readfirstlane(tid>>6);
  const long rowbase=(long)b*SEQ; const int q0=qb*QB;
  const bf16*Qw=Q+(rowbase+q0+wid*QBLK)*PQ;
  const bf16*Kh=K+rowbase*PQ,*Vh=V+rowbase*PQ;
  const unsigned lds0=(unsigned)(uintptr_t)shm;
  float*wsf=(float*)(shm+L2_WS)+wid*64;
  const bf16*ksrc=Kh+(long)lane*PQ+wid*8;
  const bf16*vsrc=Vh+(long)(16*(wid&3)+(lane>>2))*PQ+(wid>>2)*32+(lane&3)*8;
  const unsigned kdst=lds0+L2_K+wid*1024, vdst=lds0+L2_V+wid*1024;
  #define DMA_K(t,slot) glds16(ksrc+(long)(t)*KVBLK*PQ,(unsigned)__builtin_amdgcn_readfirstlane(kdst+(slot)))
  #define DMA_V(t,slot) do{ glds16(vsrc+(long)(t)*KVBLK*PQ,(unsigned)__builtin_amdgcn_readfirstlane(vdst+2*(slot))); glds16(vsrc+(long)(t)*KVBLK*PQ+64,(unsigned)__builtin_amdgcn_readfirstlane(vdst+2*(slot)+8192)); }while(0)
  const int vb0=(int)(lds0+L2_V)+((lane>>4)&1)*32+(lane&3)*8+(4*hi+((lane&15)>>2))*64;
  const char*Kbase=shm+L2_K; bf16x8 kf[8];
  const lds_cptr shm3=(lds_cptr)shm; const lds_cptr kp0=shm3+L2_K+hi*1024+r32*16; const lds_cptr vp0=shm3+L2_V+((lane>>4)&1)*32+(lane&3)*8+(4*hi+((lane&15)>>2))*64;
  const int NT=(q0+QB)/KVBLK;
  DMA_K(0,0);DMA_V(0,0);DMA_K(1,SLOTB);
  bf16x8 qr[4];
  #pragma unroll
  for(int d0=0;d0<4;++d0)qr[d0]=*reinterpret_cast<const bf16x8*>(&Qw[(long)r32*PQ+d0*16+hi*8]);
  float l_reg=0.f;f32x16 o[4];o[0]=f32x16{};o[1]=f32x16{};o[2]=f32x16{};o[3]=f32x16{};const f32x16 zz=f32x16{};
  const int qrel=wid*QBLK+r32;
  #define CMASK(P0,P1,t) do{int jb_=(t)-(NT-4); if(jb_>=0)cmask(P0,P1,jb_,qrel,hi);}while(0)
  f32x16 pA0,pA1,pB0,pB1;
  int sl_prev=0,sl_cur=0,sl_next=SLOTB;
  #define ROT() do{sl_prev=sl_cur;sl_cur=sl_next;sl_next=(sl_next==(NSLOT-1)*SLOTB)?0:sl_next+SLOTB;}while(0)
  DMA_K(2,2*SLOTB);
  WAIT_BAR(4);
  qkt(pA0,pA1,Kbase,qr,zz,r32,hi);asm volatile("s_nop 15\n\ts_nop 7":"+v"(pA0),"+v"(pA1));CMASK(pA0,pA1,0);
  _Pragma("unroll") for(int r=0;r<16;++r)pA0[r]=__builtin_amdgcn_exp2f(pA0[r]);
  _Pragma("unroll") for(int r=0;r<16;++r)pA1[r]=__builtin_amdgcn_exp2f(pA1[r]);
  WAIT_BAR(0);
  DMA_K(3,0);DMA_V(1,SLOTB);
  ROT();
  kload8(kf,kp0+sl_cur);
  WAIT_BAR(3);
  s16x4 vlo[8],vhi[8]; u32x4 pw0,pw1,pw2,pw3;
  #define PKW(P,B) cvtpk_s(P[B],P[B+1])
  #define PAF(k) __builtin_bit_cast(bf16x8,pw##k)
  #define VFR(i) (bf16x8){vlo[i][0],vlo[i][1],vlo[i][2],vlo[i][3],vhi[i][0],vhi[i][1],vhi[i][2],vhi[i][3]}
  #define PIN(x) asm volatile("":"+v"(x))
  #define GAPA(MF,A0,A1,A2,A3,W0,W1,PW) do{ MF; sacc+=A0; sacc+=A1; sacc+=A2; sacc+=A3; PIN(sacc); W0; W1; PIN(PW); SBAR(); }while(0)
  #define EX(v) __builtin_amdgcn_exp2f(v)
  #define GAPB(MF,X,B) do{ MF; X[B]=EX(X[B]); X[B+1]=EX(X[B+1]); PIN(X); SBAR(); }while(0)
  #define VRD(i) do{ vlo[i]=vtr(vp_+(((i)>>2)*4096+((i)&3)*1024)); vhi[i]=vtr(vp_+(((i)>>2)*4096+((i)&3)*1024+512)); }while(0)
  #define VRB(i) do{ vlo[i]=vtr(vp_+(8192+((i)>>2)*4096+((i)&3)*1024)); vhi[i]=vtr(vp_+(8192+((i)>>2)*4096+((i)&3)*1024+512)); SBAR(); }while(0)
  #define KRD(G,j) do{ if(G){ kload2(kf,kp0+sl_next,j); SBAR(); } }while(0)
  #define STEP(C0,C1,P0,P1,t,GK,GV,GL) do{ SBAR(); \
    const lds_cptr vp_=vp0+2*sl_prev; \
    VRD(0); SBAR(); float sacc=(P0[0]+P0[1]); \
    GAPA(C0=__builtin_amdgcn_mfma_f32_32x32x16_bf16(kf[0],qr[0],zz,0,0,0), P0[2],P0[3],P0[4],P0[5],     pw0[0]=PKW(P0,0), pw0[1]=PKW(P0,2), pw0); \
    VRD(4); SBAR(); GAPA(C1=__builtin_amdgcn_mfma_f32_32x32x16_bf16(kf[1],qr[0],zz,0,0,0), P0[6],P0[7],P0[8],P0[9],     pw0[2]=PKW(P0,4), pw0[3]=PKW(P0,6), pw0); \
    VRD(1); SBAR(); GAPA(C0=__builtin_amdgcn_mfma_f32_32x32x16_bf16(kf[2],qr[1],C0,0,0,0),   P0[10],P0[11],P0[12],P0[13], pw1[0]=PKW(P0,8), pw1[1]=PKW(P0,10), pw1); \
    VRD(5); SBAR(); GAPA(C1=__builtin_amdgcn_mfma_f32_32x32x16_bf16(kf[3],qr[1],C1,0,0,0),   P0[14],P0[15],P1[0],P1[1],   pw1[2]=PKW(P0,12),pw1[3]=PKW(P0,14), pw1); \
    VRD(2); SBAR(); GAPA(C0=__builtin_amdgcn_mfma_f32_32x32x16_bf16(kf[4],qr[2],C0,0,0,0),   P1[2],P1[3],P1[4],P1[5],     pw2[0]=PKW(P1,0), pw2[1]=PKW(P1,2), pw2); \
    VRD(6); SBAR(); GAPA(C1=__builtin_amdgcn_mfma_f32_32x32x16_bf16(kf[5],qr[2],C1,0,0,0),   P1[6],P1[7],P1[8],P1[9],     pw2[2]=PKW(P1,4), pw2[3]=PKW(P1,6), pw2); \
    VRD(3); SBAR(); GAPA(C0=__builtin_amdgcn_mfma_f32_32x32x16_bf16(kf[6],qr[3],C0,0,0,0),   P1[10],P1[11],P1[12],P1[13], pw3[0]=PKW(P1,8), pw3[1]=PKW(P1,10), pw3); \
    VRD(7); SBAR(); GAPA(C1=__builtin_amdgcn_mfma_f32_32x32x16_bf16(kf[7],qr[3],C1,0,0,0),   P1[14],P1[15],0.f,0.f,       pw3[2]=PKW(P1,12),pw3[3]=PKW(P1,14), pw3); \
    l_reg+=sacc; \
    if(GK){DMA_K((t)+3,sl_cur);} if(GV){DMA_V((t)+1,sl_next);} \
    CMASK(C0,C1,t); \
    SBAR(); \
    GAPB(o[0]=__builtin_amdgcn_mfma_f32_32x32x16_bf16(PAF(0),VFR(0),o[0],0,0,0), C0,0);  VRB(0); \
    GAPB(o[1]=__builtin_amdgcn_mfma_f32_32x32x16_bf16(PAF(0),VFR(4),o[1],0,0,0), C0,2);  VRB(4); \
    GAPB(o[0]=__builtin_amdgcn_mfma_f32_32x32x16_bf16(PAF(1),VFR(1),o[0],0,0,0), C0,4);  VRB(1); \
    GAPB(o[1]=__builtin_amdgcn_mfma_f32_32x32x16_bf16(PAF(1),VFR(5),o[1],0,0,0), C0,6);  VRB(5); \
    GAPB(o[0]=__builtin_amdgcn_mfma_f32_32x32x16_bf16(PAF(2),VFR(2),o[0],0,0,0), C0,8);  VRB(2); \
    GAPB(o[1]=__builtin_amdgcn_mfma_f32_32x32x16_bf16(PAF(2),VFR(6),o[1],0,0,0), C0,10); VRB(6); \
    GAPB(o[0]=__builtin_amdgcn_mfma_f32_32x32x16_bf16(PAF(3),VFR(3),o[0],0,0,0), C0,12); VRB(3); \
    GAPB(o[1]=__builtin_amdgcn_mfma_f32_32x32x16_bf16(PAF(3),VFR(7),o[1],0,0,0), C0,14); VRB(7); \
    GAPB(o[2]=__builtin_amdgcn_mfma_f32_32x32x16_bf16(PAF(0),VFR(0),o[2],0,0,0), C1,0); \
    GAPB(o[3]=__builtin_amdgcn_mfma_f32_32x32x16_bf16(PAF(0),VFR(4),o[3],0,0,0), C1,2); \
    KRD(GL,0); GAPB(o[2]=__builtin_amdgcn_mfma_f32_32x32x16_bf16(PAF(1),VFR(1),o[2],0,0,0), C1,4); \
    KRD(GL,1); GAPB(o[3]=__builtin_amdgcn_mfma_f32_32x32x16_bf16(PAF(1),VFR(5),o[3],0,0,0), C1,6); \
    KRD(GL,2); GAPB(o[2]=__builtin_amdgcn_mfma_f32_32x32x16_bf16(PAF(2),VFR(2),o[2],0,0,0), C1,8); \
    KRD(GL,3); GAPB(o[3]=__builtin_amdgcn_mfma_f32_32x32x16_bf16(PAF(2),VFR(6),o[3],0,0,0), C1,10); \
    GAPB(o[2]=__builtin_amdgcn_mfma_f32_32x32x16_bf16(PAF(3),VFR(3),o[2],0,0,0), C1,12); \
    GAPB(o[3]=__builtin_amdgcn_mfma_f32_32x32x16_bf16(PAF(3),VFR(7),o[3],0,0,0), C1,14); \
    }while(0)
  int t=1;
  #undef CMASK
  #define CMASK(P0,P1,t) do{}while(0)
  for(;t+5<NT;t+=2){
    STEP(pB0,pB1,pA0,pA1,t,true,true,true);     WAIT_BAR(3); ROT();
    STEP(pA0,pA1,pB0,pB1,t+1,true,true,true);   WAIT_BAR(3); ROT();
  }
  #undef CMASK
  #define CMASK(P0,P1,t) do{int jb_=(t)-(NT-4); if(jb_>=0)cmask(P0,P1,jb_,qrel,hi);}while(0)
  #define ENDW(tt) do{ if((tt)+3<NT){WAIT_BAR(3);} else if((tt)+2<NT){WAIT_BAR(2);} else {WAIT_BAR(0);} }while(0)
  for(;t+1<NT;t+=2){
    STEP(pB0,pB1,pA0,pA1,t,(t+3<NT),(t+1<NT),(t+1<NT));       ENDW(t);   ROT();
    STEP(pA0,pA1,pB0,pB1,t+1,(t+4<NT),(t+2<NT),(t+2<NT));     ENDW(t+1); ROT();
  }
  STEP(pB0,pB1,pA0,pA1,NT-1,false,false,false);
  { float sacc=pB0[0]+pB0[1]; _Pragma("unroll") for(int r=2;r<16;++r)sacc+=pB0[r]; _Pragma("unroll") for(int r=0;r<16;++r)sacc+=pB1[r]; l_reg+=sacc;
    pw0=(u32x4){PKW(pB0,0),PKW(pB0,2),PKW(pB0,4),PKW(pB0,6)};pw1=(u32x4){PKW(pB0,8),PKW(pB0,10),PKW(pB0,12),PKW(pB0,14)};pw2=(u32x4){PKW(pB1,0),PKW(pB1,2),PKW(pB1,4),PKW(pB1,6)};pw3=(u32x4){PKW(pB1,8),PKW(pB1,10),PKW(pB1,12),PKW(pB1,14)};
    SBAR(); pv(o,vb0+2*sl_cur,PAF(0),PAF(1),PAF(2),PAF(3)); pv(o+2,vb0+2*sl_cur+8192,PAF(0),PAF(1),PAF(2),PAF(3)); }
  #undef PKW
  #undef PAF
  #undef VFR
  #undef PIN
  #undef GAPA
  #undef GAPB
  #undef EX
  #undef VRD
  #undef VRB
  #undef KRD
  #undef STEP
  #undef ENDW
  {auto rr=__builtin_amdgcn_permlane32_swap(__float_as_uint(l_reg),__float_as_uint(l_reg),false,false);l_reg=__uint_as_float(rr[0])+__uint_as_float(rr[1]);}
  if(hi==0)wsf[32+r32]=l_reg;asm volatile("s_waitcnt lgkmcnt(0)":::"memory");
  float rli[16];
  #pragma unroll
  for(int r=0;r<16;++r)rli[r]=__builtin_amdgcn_rcpf(wsf[32+crow(r,hi)]);
  bf16*Ow=O+(rowbase+q0+wid*QBLK)*PO;
  { bf16*stg=(bf16*)(shm+L2_OST)+wid*2048;
    #pragma unroll
    for(int hh=0;hh<2;++hh){
      #pragma unroll
      for(int r=0;r<16;++r){const int orow=crow(r,hi);
        #pragma unroll
        for(int d0=0;d0<2;++d0)stg[orow*64+d0*32+r32]=__float2bfloat16(o[2*hh+d0][r]*rli[r]);}
      asm volatile("s_waitcnt lgkmcnt(0)":::"memory");
      #pragma unroll
      for(int i=0;i<4;++i){const int row=i*8+(lane>>3),ch=lane&7; const u32x4 v=*(const u32x4*)(stg+row*64+ch*8); ATTN_STORE16(Ow+(long)row*PO+hh*64+ch*8,v);}
      asm volatile("s_waitcnt lgkmcnt(0)":::"memory"); } }
  asm volatile("s_waitcnt lgkmcnt(0)\n\ts_barrier":::"memory");
  #undef DMA_K
  #undef DMA_V
  #undef CMASK
  #undef ROT
}
struct StaticOrder2 {
  int vcu;
  __device__ __forceinline__ explicit StaticOrder2(int grid,int block):vcu((block%8)*(grid/8)+block/8){}
  __device__ __forceinline__ bool next(int i,AttnUnit&u)const{ if(i>=2)return false; const int s=vcu&15; u.bh=vcu>>4; u.qb=(i==0)?s:31-s; return true; }
};
__device__ __forceinline__ void attn_phase2(char*lds,const AttnTensors&T,const StaticOrder2&S){
  AttnUnit u;
  for(int i=0;S.next(i,u);++i){ const int b=u.bh>>3, hm=u.bh&7; attn_unit2(b,u.qb,T.P+2048+hm*64,T.P+2560+hm*64,T.P+3072+(hm>>1)*128,T.O+hm*128,lds); }
}
#undef SBAR
#undef WAIT_BAR
}
constexpr int NWAVES = 8;
constexpr int PER_PHASE = 8;
constexpr int T = 8192, D = 1024, M = 16384, NIN = 3584, FF = 2816, NGU = 5632;
constexpr float EPSN = 1e-6f;
constexpr size_t MiB = 1u << 20;
constexpr size_t WS_CTL = 0, CTL_ZERO_BYTES = 1 * MiB;
constexpr size_t WS_WIN = 2 * MiB, WS_WOUT = 9 * MiB, WS_WGU = 11 * MiB, WS_WDN = 22 * MiB;
constexpr size_t WS_ROPEC = 28 * MiB, WS_ROPES = 29 * MiB, WS_RSTD1 = 30 * MiB, WS_SS2 = 31 * MiB;
constexpr size_t WS_XN = 32 * MiB;
constexpr size_t WS_KV = 32 * MiB;
constexpr size_t WS_P = 64 * MiB;
constexpr size_t WS_H = 64 * MiB;
constexpr size_t WS_O = 176 * MiB, WS_MIX = 208 * MiB, WS_END = 240 * MiB;
static_assert(WS_WDN + (size_t)D * FF * 2 <= WS_ROPEC && WS_P + (size_t)M * NIN * 2 <= WS_O && WS_H + (size_t)M * FF * 2 <= WS_O && WS_KV + (size_t)1024 * 4096 * 4 <= WS_P, "d_ws map");
constexpr int CW_TMO = 0, CW_CODE = 1, CW_BAR = 4096;
constexpr int RING_OFF = 0, RING_BYTES = 131072;
constexpr int LDSCTL_OFF = RING_BYTES, MISC_OFF = LDSCTL_OFF + 320;
constexpr int LDS_BYTES = 147456;
#define GAS __attribute__((address_space(1)))
#define LAS __attribute__((address_space(3)))
typedef unsigned short bf16;
typedef unsigned v4u __attribute__((ext_vector_type(4)));
typedef float f32x4 __attribute__((ext_vector_type(4)));
typedef short bf16x8 __attribute__((ext_vector_type(8)));
typedef GAS unsigned gu32;
typedef GAS unsigned long long gu64;
#define RLX_AGENT __ATOMIC_RELAXED, __HIP_MEMORY_SCOPE_AGENT
#define LDS_WAIT() asm volatile("s_waitcnt lgkmcnt(0)" ::: "memory")
#define VM_WAIT() asm volatile("s_waitcnt vmcnt(0)" ::: "memory")
__device__ __forceinline__ unsigned long long rt() { return __builtin_amdgcn_s_memrealtime(); }
typedef float f32x2_cv __attribute__((ext_vector_type(2))); typedef __bf16 bf16x2_cv __attribute__((ext_vector_type(2)));
__device__ __forceinline__ unsigned pk2(float lo, float hi) { const f32x2_cv v = {lo, hi}; return __builtin_bit_cast(unsigned, __builtin_convertvector(v, bf16x2_cv)); }
__device__ __forceinline__ unsigned f2bf(float f) { return pk2(f, 0.f) & 0xffffu; }

#define XB_TMO      128
#define XB_XCNT(j)  (256  + 64 * (j))
#define XB_XSUB(j)  (1280 + 64 * (j))
#define XB_XGEN(j)  (2304 + 64 * (j))
#define XB_TOP      3328
#define XB_TOPGEN   3392
#define XCD_BAR_WORDS 3456
#define XB_SPIN_CAP (1u << 18)

__device__ __forceinline__ unsigned xb_ld(unsigned* p)              { return __hip_atomic_load(p, __ATOMIC_RELAXED, __HIP_MEMORY_SCOPE_AGENT); }
__device__ __forceinline__ unsigned xb_add(unsigned* p, unsigned v) { return __hip_atomic_fetch_add(p, v, __ATOMIC_RELAXED, __HIP_MEMORY_SCOPE_AGENT); }
__device__ __forceinline__ unsigned xb_xcc_id() { return (unsigned)__builtin_amdgcn_s_getreg((3 << 11) | 20) & 0xFu; }
#define XB_SPIN(cond, bar) do { unsigned _sp = 0; while (cond) { __builtin_amdgcn_s_sleep(1); \
    if ((++_sp & 255u) == 0u) { if (xb_ld(&(bar)[XB_TMO])) break; if (_sp > XB_SPIN_CAP) { atomicAdd(&(bar)[XB_TMO], 1u); break; } } } } while (0)

struct XcdBarrier {
    unsigned* bar; unsigned x;
    volatile LAS unsigned* st;
};

__device__ __forceinline__ XcdBarrier xcd_barrier_post(unsigned* bar, volatile LAS unsigned* st) {
    XcdBarrier b; b.bar = bar; b.x = xb_xcc_id(); b.st = st;
    if (threadIdx.x == 0) (void)xb_add(&bar[XB_XCNT(b.x)], 1u);
    return b;
}
__device__ __forceinline__ void xcd_barrier_complete(unsigned* bar, unsigned x, unsigned& nloc, unsigned& nx) {
    const unsigned G = gridDim.x * gridDim.y * gridDim.z;
    unsigned sum, cnt, mine, sp = 0u;
    for (;;) {
        sum = 0u; cnt = 0u; mine = 0u;
#pragma unroll
        for (unsigned j = 0; j < 16; ++j) { const unsigned c = xb_ld(&bar[XB_XCNT(j)]); sum += c; cnt += (c > 0u) ? 1u : 0u; mine = (j == x) ? c : mine; }
        if (sum == G) break;
        __builtin_amdgcn_s_sleep(1);
        if ((++sp & 255u) == 0u) { if (xb_ld(&bar[XB_TMO])) break; if (sp > XB_SPIN_CAP) { atomicAdd(&bar[XB_TMO], 1u); break; } }
    }
    nloc = mine > 0u ? mine : 1u; nx = cnt > 0u ? cnt : 1u;
}

__device__ __forceinline__ void xcd_barrier(const XcdBarrier& b) {
    asm volatile("s_waitcnt vmcnt(0)" ::: "memory");
    __syncthreads();
    if (threadIdx.x == 0) {
        unsigned* bar = b.bar;
        __builtin_amdgcn_s_waitcnt(0);
        unsigned nloc = b.st[0], nx = b.st[1];
        if (nloc == 0u) { xcd_barrier_complete(bar, b.x, nloc, nx); b.st[0] = nloc; b.st[1] = nx; }
        const unsigned old = xb_add(&bar[XB_XSUB(b.x)], 1u);
        const unsigned gen = old / nloc;
        if (old + 1u == (gen + 1u) * nloc) {
            __builtin_amdgcn_fence(__ATOMIC_RELEASE, "agent");
            asm volatile("s_waitcnt vmcnt(0)" ::: "memory");
            const unsigned og = xb_add(&bar[XB_TOP], 1u);
            const unsigned tg = og / nx;
            if (og + 1u == (tg + 1u) * nx) xb_add(&bar[XB_TOPGEN], 1u);
            else XB_SPIN(xb_ld(&bar[XB_TOPGEN]) == tg, bar);
            __builtin_amdgcn_fence(__ATOMIC_ACQUIRE, "agent");
            xb_add(&bar[XB_XGEN(b.x)], 1u);
            asm volatile("s_waitcnt vmcnt(0)" ::: "memory");
        } else {
            XB_SPIN(xb_ld(&bar[XB_XGEN(b.x)]) == gen, bar);
            __builtin_amdgcn_fence(__ATOMIC_ACQUIRE, "agent");
            asm volatile("s_waitcnt vmcnt(0)" ::: "memory");
        }
    }
    __syncthreads();
}
struct Frame {
    LAS unsigned char* lds;
    volatile LAS unsigned* MISC;
    gu32* ctl;
    int tid, lane, wave;
    int vcu, G;
    const float *x, *g1, *w_in, *retg, *gq, *gk, *lq1, *lk1, *lq2, *lk2, *gsub, *w_out, *g2, *w_gate, *w_up, *w_down;
    float* out;
    bf16 *Win_t, *Wout_t, *Wgu_t, *Wdn_t;
    float *ropec, *ropes, *rstd1, *ss2, *KV;
    bf16 *XN, *P, *HB, *O, *MIX;
};
__device__ __forceinline__ float wave_sum_bperm(float v) {
#pragma unroll
    for (int o = 1; o < 64; o <<= 1) v += __shfl_xor(v, o);
    return v;
}
__device__ __forceinline__ float bflo(unsigned w) { return __uint_as_float(w << 16); }
__device__ __forceinline__ float bfhi(unsigned w) { return __uint_as_float(w & 0xffff0000u); }
template <int CTRL> __device__ __forceinline__ float dpp_mov(float v) { return __int_as_float(__builtin_amdgcn_update_dpp(0, __float_as_int(v), CTRL, 0xF, 0xF, true)); }
__device__ __forceinline__ float sum16(float v) {
    v += dpp_mov<0xB1>(v); v += dpp_mov<0x4E>(v); v += dpp_mov<0x141>(v); v += dpp_mov<0x140>(v); return v;
}
__device__ __forceinline__ float wave_sum(float v) { return pg8::sum_rows4(sum16(v)); }
__device__ __forceinline__ float ret_lg2(int h) {
    const float xx = __builtin_amdgcn_exp2f(-(float)(5 + h));
    float p = 0.125f; p = p * xx + (1.f / 7.f); p = p * xx + (1.f / 6.f); p = p * xx + 0.2f; p = p * xx + 0.25f; p = p * xx + (1.f / 3.f); p = p * xx + 0.5f; p = p * xx + 1.f;
    return -xx * p * 1.4426950408889634f;
}
__device__ __forceinline__ void p0_transpose_item(const float* W, int K, int N, bf16* WT, int mode, const float* kscale, LAS unsigned short* scr, int item, int lane) {
    const int nblk = N / 64, kb = item / nblk, nb = item % nblk, k0 = 64 * kb, n0 = 64 * nb;
    const int c = lane & 15, kr = lane >> 4;
    f32x4 v[16];
#pragma unroll
    for (int i = 0; i < 16; ++i) v[i] = *(const GAS f32x4*)(W + (size_t)(k0 + 4 * i + kr) * N + n0 + 4 * c);
#pragma unroll
    for (int i = 0; i < 16; ++i) { const int k = 4 * i + kr; const float sc = kscale ? kscale[k0 + k] : 1.f; LAS unsigned short* p = scr + (4 * c) * 72 + k;
        p[0] = (unsigned short)f2bf(v[i].x * sc); p[72] = (unsigned short)f2bf(v[i].y * sc); p[144] = (unsigned short)f2bf(v[i].z * sc); p[216] = (unsigned short)f2bf(v[i].w * sc); }
    LDS_WAIT(); asm volatile("" ::: "memory");
    int obase;
    if (mode == 1) obase = (n0 & ~255) + (((n0 & 255) >> 6) * 32);
    else if (mode == 2) obase = (n0 >> 7) * 256 + (n0 & 127);
    else if (mode == 3) obase = (n0 >> 7) * 256 + 128 + (n0 & 127);
    else obase = n0;
    const int hstep = (mode == 1) ? 128 : 32, ch = lane & 7;
#pragma unroll
    for (int j = 0; j < 8; ++j) { const int n = 8 * j + (lane >> 3); const v4u o = *(const LAS v4u*)(scr + n * 72 + 8 * ch);
        const int orow = obase + (n >> 5) * hstep + (n & 31);
        *(GAS v4u*)(WT + (size_t)orow * K + k0 + 8 * ch) = o; }
    LDS_WAIT(); asm volatile("" ::: "memory");
}
__device__ __forceinline__ void p0_prologue(Frame& F) {
    LAS unsigned short* scr = (LAS unsigned short*)(F.lds + F.wave * 16384);
    const int gw = F.vcu * NWAVES + F.wave, NGW = F.G * NWAVES;
    constexpr int I_IN = (D / 64) * (NIN / 64);
    for (int it = gw; it < I_IN; it += NGW) p0_transpose_item(F.w_in, D, NIN, F.Win_t, 1, F.g1, scr, it, F.lane);
    for (int m = gw; m < M; m += 2 * NGW) {
        const int m2 = (m + NGW < M) ? m + NGW : m;
        const GAS f32x4* xa = (const GAS f32x4*)(F.x + (size_t)m * D) + F.lane; const GAS f32x4* xb = (const GAS f32x4*)(F.x + (size_t)m2 * D) + F.lane; f32x4 va[4], vb[4]; float sa = 0.f, sb = 0.f;
#pragma unroll
        for (int j = 0; j < 4; ++j) { va[j] = __builtin_nontemporal_load(xa + 64 * j); vb[j] = __builtin_nontemporal_load(xb + 64 * j); }
#pragma unroll
        for (int j = 0; j < 4; ++j) { sa += (va[j].x * va[j].x + va[j].y * va[j].y) + (va[j].z * va[j].z + va[j].w * va[j].w); sb += (vb[j].x * vb[j].x + vb[j].y * vb[j].y) + (vb[j].z * vb[j].z + vb[j].w * vb[j].w); }
        sa = wave_sum(sa); sb = wave_sum(sb);
        GAS unsigned long long* oa = (GAS unsigned long long*)(F.XN + (size_t)m * D) + F.lane; GAS unsigned long long* ob = (GAS unsigned long long*)(F.XN + (size_t)m2 * D) + F.lane;
#pragma unroll
        for (int j = 0; j < 4; ++j) { oa[64 * j] = (unsigned long long)pk2(va[j].x, va[j].y) | ((unsigned long long)pk2(va[j].z, va[j].w) << 32);
            ob[64 * j] = (unsigned long long)pk2(vb[j].x, vb[j].y) | ((unsigned long long)pk2(vb[j].z, vb[j].w) << 32); }
        if (F.lane == 0) { F.rstd1[m] = rsqrtf(sa * (1.f / D) + EPSN); F.rstd1[m2] = rsqrtf(sb * (1.f / D) + EPSN); }
    }
    for (int i = gw * 64 + F.lane; i < T * 32; i += NGW * 64) {
        const int pos = i >> 5, fi = i & 31;
        const float freq = __builtin_amdgcn_exp2f(-(float)fi * (13.287712379549449f / 32.0f));
        const double rev = (double)pos * (double)freq * 0.15915494309189535;
        const float fr = (float)(rev - __builtin_floor(rev));
        F.ropec[i] = __builtin_amdgcn_cosf(fr); F.ropes[i] = __builtin_amdgcn_sinf(fr);
    }
}
typedef float f32x16 __attribute__((ext_vector_type(16)));
constexpr int RL_Q = 0, RL_K = 18432, RL_KT = 36864, RL_OF = RL_K, RL_VT = 54272, RL_AM = 71680, RL_ST = 106496;
__device__ __forceinline__ int crow16(int r, int hi) { return (r & 3) + 8 * (r >> 2) + 4 * hi; }
__device__ __forceinline__ bf16x8 rfrag(const LAS unsigned char* p) { return *(const LAS bf16x8*)p; }
__device__ __forceinline__ void p0_deferred(Frame& F) {
    LAS unsigned short* scr = (LAS unsigned short*)(F.lds + F.wave * 16384);
    const int nb = (int)F.G - 128; if (nb <= 0 || (int)blockIdx.x < 128) return;
    const int gw = ((int)blockIdx.x - 128) * NWAVES + F.wave, NGW = nb * NWAVES;
    constexpr int I_OUT = (D / 64) * (D / 64), I_G = (D / 64) * (FF / 64), I_DN = (FF / 64) * (D / 64);
    for (int it = gw; it < I_OUT + 2 * I_G + I_DN; it += NGW) {
        int r = it;
        if (r < I_OUT) { p0_transpose_item(F.w_out, D, D, F.Wout_t, 0, nullptr, scr, r, F.lane); continue; } r -= I_OUT;
        if (r < I_G) { p0_transpose_item(F.w_gate, D, FF, F.Wgu_t, 2, F.g2, scr, r, F.lane); continue; } r -= I_G;
        if (r < I_G) { p0_transpose_item(F.w_up, D, FF, F.Wgu_t, 3, F.g2, scr, r, F.lane); continue; } r -= I_G;
        p0_transpose_item(F.w_down, FF, D, F.Wdn_t, 0, nullptr, scr, r, F.lane);
    }
}
typedef unsigned u32x2g __attribute__((ext_vector_type(2)));
struct RetRegs { v4u a[8]; u32x2g g[4]; };
__device__ __forceinline__ void ret_load(RetRegs& R, const bf16* Pb, int tid, bool withQ) {
#pragma unroll
    for (int c = 0; c < 8; ++c) R.a[c] = (v4u){0u, 0u, 0u, 0u};
#pragma unroll
    for (int c = 0; c < 4; ++c) R.g[c] = (u32x2g){0u, 0u};
    if (tid < 256) { const bf16* p = Pb + (size_t)(tid & 127) * NIN + (tid < 128 ? 512 : 1024);
#pragma unroll
        for (int c8 = 0; c8 < 8; ++c8) R.a[c8] = *(const GAS v4u*)(p + 8 * c8); }
    else if (withQ) { const int t = tid - 256; const bf16* p = Pb + (size_t)(t >> 1) * NIN + 32 * (t & 1);
#pragma unroll
        for (int c = 0; c < 4; ++c) R.a[c] = *(const GAS v4u*)(p + 8 * c); }
    if (withQ) {
#pragma unroll
        for (int rr = 0; rr < 4; ++rr) R.g[rr] = *(const GAS u32x2g*)(Pb + (size_t)(4 * (tid >> 4) + rr) * NIN + 1536 + 4 * (tid & 15)); }
}
__device__ __forceinline__ void ret_store(Frame& F, const RetRegs& R, float lg2, bool withQ) {
    LAS unsigned char* L = F.lds; const int tid = F.tid;
    if (tid < 128) { const int j = tid; const float sc = __builtin_amdgcn_exp2f(-lg2 * (float)j);
#pragma unroll
        for (int c8 = 0; c8 < 8; ++c8) { const v4u kk = R.a[c8];
            v4u kp; kp.x = pk2(bflo(kk.x) * sc, bfhi(kk.x) * sc); kp.y = pk2(bflo(kk.y) * sc, bfhi(kk.y) * sc); kp.z = pk2(bflo(kk.z) * sc, bfhi(kk.z) * sc); kp.w = pk2(bflo(kk.w) * sc, bfhi(kk.w) * sc);
            *(LAS v4u*)(L + RL_K + j * 144 + c8 * 16) = kp;
            LAS unsigned short* kt = (LAS unsigned short*)(L + RL_KT) + (8 * c8) * 136 + j;
            kt[0] = (unsigned short)kp.x; kt[136] = (unsigned short)(kp.x >> 16); kt[272] = (unsigned short)kp.y; kt[408] = (unsigned short)(kp.y >> 16);
            kt[544] = (unsigned short)kp.z; kt[680] = (unsigned short)(kp.z >> 16); kt[816] = (unsigned short)kp.w; kt[952] = (unsigned short)(kp.w >> 16); } }
    else if (tid < 256) { const int j = tid - 128;
#pragma unroll
        for (int c8 = 0; c8 < 8; ++c8) { const v4u vv = R.a[c8]; LAS unsigned short* vt = (LAS unsigned short*)(L + RL_VT) + (8 * c8) * 136 + j;
            vt[0] = (unsigned short)vv.x; vt[136] = (unsigned short)(vv.x >> 16); vt[272] = (unsigned short)vv.y; vt[408] = (unsigned short)(vv.y >> 16);
            vt[544] = (unsigned short)vv.z; vt[680] = (unsigned short)(vv.z >> 16); vt[816] = (unsigned short)vv.w; vt[952] = (unsigned short)(vv.w >> 16); } }
    else if (withQ) { const int t = tid - 256, i = t >> 1, hq = t & 1; const float sq = __builtin_amdgcn_exp2f(lg2 * (float)i);
#pragma unroll
        for (int c = 0; c < 4; ++c) { const v4u qq = R.a[c];
            v4u qp; qp.x = pk2(bflo(qq.x) * sq, bfhi(qq.x) * sq); qp.y = pk2(bflo(qq.y) * sq, bfhi(qq.y) * sq); qp.z = pk2(bflo(qq.z) * sq, bfhi(qq.z) * sq); qp.w = pk2(bflo(qq.w) * sq, bfhi(qq.w) * sq);
            *(LAS v4u*)(L + RL_Q + i * 144 + (4 * hq + c) * 16) = qp; } }
}
__device__ __forceinline__ f32x16 ret_kv_tile(Frame& F, int dt, int et) {
    const int r32 = F.lane & 31, hi = F.lane >> 5; f32x16 kv = {};
    const LAS unsigned char* ap = F.lds + RL_KT + (32 * dt + r32) * 272 + hi * 16; const LAS unsigned char* bp = F.lds + RL_VT + (32 * et + r32) * 272 + hi * 16;
#pragma unroll
    for (int jk = 0; jk < 8; ++jk) kv = __builtin_amdgcn_mfma_f32_32x32x16_bf16(rfrag(ap + jk * 32), rfrag(bp + jk * 32), kv, 0, 0, 0);
    return kv;
}
#define RET_BAR() asm volatile("s_waitcnt lgkmcnt(0)\n\ts_barrier" ::: "memory")
__device__ __forceinline__ void ret_state_unit(Frame& F, int bh, int n4) {
    const int b = bh >> 3, h = bh & 7, w = F.wave, r32 = F.lane & 31, hi = F.lane >> 5, dt = (w >> 1) & 1, et = w & 1;
    const float lg2 = ret_lg2(h), cd = __builtin_amdgcn_exp2f(lg2 * 128.f), g127 = __builtin_amdgcn_exp2f(lg2 * 127.f);
    f32x16 Sr = {};
    const bf16* Pb0 = F.P + ((size_t)b * T + (4 * n4) * 128) * NIN + h * 64;
    RetRegs R; ret_load(R, Pb0, F.tid, false);
    for (int c = 0; c < 4; ++c) {
        ret_store(F, R, lg2, false);
        if (c < 3) ret_load(R, Pb0 + (size_t)(c + 1) * 128 * NIN, F.tid, false);
        RET_BAR();
        if (w < 4) { const f32x16 kv = ret_kv_tile(F, dt, et); Sr = Sr * cd + kv * g127; }
        RET_BAR();
    }
    if (w < 4) { float* gp = F.KV + (size_t)(bh * 16 + n4) * 4096 + (32 * dt) * 64 + 32 * et + r32;
#pragma unroll
        for (int r = 0; r < 16; ++r) gp[crow16(r, hi) * 64] = Sr[r]; }
}
__device__ __forceinline__ void ret_unit(Frame& F, int bh, int n4) {
    typedef unsigned u32x2 __attribute__((ext_vector_type(2)));
    const int b = bh >> 3, h = bh & 7, tid = F.tid, w = F.wave, r32 = F.lane & 31, hi = F.lane >> 5;
    LAS unsigned char* L = F.lds;
    const float lg2 = ret_lg2(h), cd = __builtin_amdgcn_exp2f(lg2 * 128.f), g127 = __builtin_amdgcn_exp2f(lg2 * 127.f), gam = __builtin_amdgcn_exp2f(lg2), cd4 = __builtin_amdgcn_exp2f(lg2 * 512.f);
    const int dt = (w >> 1) & 1, et = w & 1;
    f32x16 Sr = {};
    const bf16* Pb0 = F.P + ((size_t)b * T + (4 * n4) * 128) * NIN + h * 64;
    RetRegs R; ret_load(R, Pb0, tid, true);
    {
        const float* gp = F.KV + (size_t)(bh * 16) * 4096 + tid * 8; f32x4 s0 = {0.f, 0.f, 0.f, 0.f}, s1 = s0; float wgt = 1.f;
#pragma unroll 4
        for (int m = n4 - 1; m >= 0; --m) { const f32x4 a0 = *(const GAS f32x4*)(gp + (size_t)m * 4096), a1 = *(const GAS f32x4*)(gp + (size_t)m * 4096 + 4); s0 += a0 * wgt; s1 += a1 * wgt; wgt *= cd4; }
        LAS float* sf = (LAS float*)(L + RL_AM);
        *(LAS f32x4*)(sf + tid * 8) = s0; *(LAS f32x4*)(sf + tid * 8 + 4) = s1;
        RET_BAR();
        if (w < 4) {
#pragma unroll
            for (int r = 0; r < 16; ++r) Sr[r] = sf[(32 * dt + crow16(r, hi)) * 64 + 32 * et + r32];
            LAS unsigned short* st = (LAS unsigned short*)(L + RL_ST) + (32 * et + r32) * 72 + 32 * dt;
#pragma unroll
            for (int r = 0; r < 16; ++r) st[crow16(r, hi)] = (unsigned short)f2bf(Sr[r]);
        }
        RET_BAR();
    }
    const f32x4 g4 = *(const f32x4*)(F.retg + h * 64 + 4 * (tid & 15));
    for (int c = 0; c < 4; ++c) {
        const size_t r0 = (size_t)b * T + (4 * n4 + c) * 128; const bf16* Pb = F.P + r0 * NIN + h * 64;
        ret_store(F, R, lg2, true);
        const u32x2g gcur[4] = {R.g[0], R.g[1], R.g[2], R.g[3]};
        if (c < 3) ret_load(R, Pb + (size_t)128 * NIN, tid, true);
        RET_BAR();
#define RET_ATILE(IT, JT) do { const int it_ = (IT), jt_ = (JT); f32x16 a_ = {}; \
            const LAS unsigned char* ap_ = L + RL_Q + (32 * it_ + r32) * 144 + hi * 16; const LAS unsigned char* bp_ = L + RL_K + (32 * jt_ + r32) * 144 + hi * 16; \
            _Pragma("unroll") for (int d0 = 0; d0 < 4; ++d0) a_ = __builtin_amdgcn_mfma_f32_32x32x16_bf16(rfrag(ap_ + d0 * 32), rfrag(bp_ + d0 * 32), a_, 0, 0, 0); \
            LAS unsigned short* am_ = (LAS unsigned short*)(L + RL_AM) + (32 * it_) * 136 + 32 * jt_ + r32; \
            _Pragma("unroll") for (int r = 0; r < 16; ++r) { const int il = crow16(r, hi); const float v_ = (jt_ < it_ || il >= r32) ? a_[r] : 0.f; am_[il * 136] = (unsigned short)f2bf(v_); } } while (0)
        if (w < 4) { const f32x16 kv = ret_kv_tile(F, dt, et); Sr = Sr * cd + kv * g127; RET_ATILE(w, w); }
        else if (w == 4) { RET_ATILE(1, 0); RET_ATILE(2, 0); }
        else if (w == 5) { RET_ATILE(2, 1); RET_ATILE(3, 0); }
        else if (w == 6) { RET_ATILE(3, 1); }
        else { RET_ATILE(3, 2); }
#undef RET_ATILE
        RET_BAR();
        {
            const int it = w >> 1; f32x16 o1 = {}, o2 = {};
            const LAS unsigned char* ap = L + RL_AM + (32 * it + r32) * 272 + hi * 16; const LAS unsigned char* bp = L + RL_VT + (32 * et + r32) * 272 + hi * 16;
            for (int jk = 0; jk < 2 * (it + 1); ++jk) o1 = __builtin_amdgcn_mfma_f32_32x32x16_bf16(rfrag(ap + jk * 32), rfrag(bp + jk * 32), o1, 0, 0, 0);
            const LAS unsigned char* qp = L + RL_Q + (32 * it + r32) * 144 + hi * 16; const LAS unsigned char* sp = L + RL_ST + (32 * et + r32) * 144 + hi * 16;
#pragma unroll
            for (int d0 = 0; d0 < 4; ++d0) o2 = __builtin_amdgcn_mfma_f32_32x32x16_bf16(rfrag(qp + d0 * 32), rfrag(sp + d0 * 32), o2, 0, 0, 0);
            LAS float* of = (LAS float*)(L + RL_OF) + (32 * it) * 68 + 32 * et + r32;
#pragma unroll
            for (int r = 0; r < 16; ++r) of[crow16(r, hi) * 68] = o1[r] + gam * o2[r];
        }
        RET_BAR();
        {
            const int eg = tid & 15, rq = tid >> 4;
#pragma unroll
            for (int rr = 0; rr < 4; ++rr) { const int row = 4 * rq + rr; const f32x4 o = *(const LAS f32x4*)((LAS float*)(L + RL_OF) + row * 68 + 4 * eg);
                float ss = (o[0] * o[0] + o[1] * o[1]) + (o[2] * o[2] + o[3] * o[3]);
                ss = sum16(ss);
                const float rn = rsqrtf(ss * (1.f / 64.f) + EPSN);
                const u32x2g gg = gcur[rr]; const float gt[4] = {bflo(gg.x), bfhi(gg.x), bflo(gg.y), bfhi(gg.y)}; float y[4];
#pragma unroll
                for (int e = 0; e < 4; ++e) y[e] = o[e] * rn * g4[e] * gt[e] * __builtin_amdgcn_rcpf(1.f + __builtin_amdgcn_exp2f(-1.4426950408889634f * gt[e]));
                u32x2 wv; wv.x = pk2(y[0], y[1]); wv.y = pk2(y[2], y[3]);
                *(GAS u32x2*)(F.MIX + (r0 + row) * 1024 + h * 64 + 4 * eg) = wv; }
        }
        if (w < 4) { LAS unsigned short* st = (LAS unsigned short*)(L + RL_ST) + (32 * et + r32) * 72 + 32 * dt;
#pragma unroll
            for (int r = 0; r < 16; ++r) st[crow16(r, hi)] = (unsigned short)f2bf(Sr[r]); }
        RET_BAR();
    }
}
__device__ __forceinline__ void difmix_rows(Frame& F) {
    const float la = wave_sum(F.lq1[F.lane] * F.lk1[F.lane]), lb = wave_sum(F.lq2[F.lane] * F.lk2[F.lane]);
    const float lam = __expf(la) - __expf(lb) + 0.2f;
    const int h = F.lane >> 4, e8 = (F.lane & 15) * 8;
    const f32x4 ga = *(const f32x4*)(F.gsub + e8), gb = *(const f32x4*)(F.gsub + e8 + 4);
    const int gw = F.vcu * NWAVES + F.wave, NGW = F.G * NWAVES;
    for (int row0 = gw; row0 < M; row0 += 4 * NGW) {
        int rows[4]; v4u o1[4], o2[4];
#pragma unroll
        for (int q = 0; q < 4; ++q) { rows[q] = (row0 + q * NGW < M) ? row0 + q * NGW : row0;
            o1[q] = *(const GAS v4u*)(F.O + (size_t)rows[q] * 1024 + h * 256 + e8); o2[q] = *(const GAS v4u*)(F.O + (size_t)rows[q] * 1024 + h * 256 + 128 + e8); }
#pragma unroll
        for (int q = 0; q < 4; ++q) {
            float d[8];
            d[0] = bflo(o1[q].x) - lam * bflo(o2[q].x); d[1] = bfhi(o1[q].x) - lam * bfhi(o2[q].x); d[2] = bflo(o1[q].y) - lam * bflo(o2[q].y); d[3] = bfhi(o1[q].y) - lam * bfhi(o2[q].y);
            d[4] = bflo(o1[q].z) - lam * bflo(o2[q].z); d[5] = bfhi(o1[q].z) - lam * bfhi(o2[q].z); d[6] = bflo(o1[q].w) - lam * bflo(o2[q].w); d[7] = bfhi(o1[q].w) - lam * bfhi(o2[q].w);
            float ss = 0.f;
#pragma unroll
            for (int i = 0; i < 8; ++i) ss += d[i] * d[i];
            ss = sum16(ss);
            const float r = rsqrtf(ss * (1.f / 128.f) + EPSN) * 0.8f;
            v4u w; w.x = pk2(d[0] * r * ga[0], d[1] * r * ga[1]); w.y = pk2(d[2] * r * ga[2], d[3] * r * ga[3]); w.z = pk2(d[4] * r * gb[0], d[5] * r * gb[1]); w.w = pk2(d[6] * r * gb[2], d[7] * r * gb[3]);
            *(GAS v4u*)(F.MIX + (size_t)rows[q] * 1024 + 512 + h * 128 + e8) = w;
        }
    }
}

__device__ __forceinline__ void attn_fallback(Frame& F) {
    LAS float* Ks = (LAS float*)(F.lds); LAS float* Vs = (LAS float*)(F.lds + 16384);
    const int tid = F.tid, qi = tid & 63, ec = tid >> 6;
    for (int it = F.vcu; it < 2048; it += F.G) {
        const int b = it >> 10, hm = (it >> 7) & 7, qb = it & 127;
        const bf16* Pq = F.P + ((size_t)b * T + qb * 64 + qi) * NIN + 2048 + hm * 64;
        float q[64], o[16], m = -INFINITY, l = 0.f;
#pragma unroll
        for (int c = 0; c < 8; ++c) { const v4u w = *(const GAS v4u*)(Pq + 8 * c); q[8 * c] = bflo(w.x); q[8 * c + 1] = bfhi(w.x); q[8 * c + 2] = bflo(w.y); q[8 * c + 3] = bfhi(w.y); q[8 * c + 4] = bflo(w.z); q[8 * c + 5] = bfhi(w.z); q[8 * c + 6] = bflo(w.w); q[8 * c + 7] = bfhi(w.w); }
#pragma unroll
        for (int i = 0; i < 16; ++i) o[i] = 0.f;
        for (int kt = 0; kt <= qb; ++kt) {
            const bf16* Pk = F.P + ((size_t)b * T + kt * 64) * NIN;
            { const int j = tid >> 3, c8 = tid & 7; const v4u w = *(const GAS v4u*)(Pk + (size_t)j * NIN + 2560 + hm * 64 + 8 * c8); LAS f32x4* kp = (LAS f32x4*)(Ks + j * 64 + 8 * c8);
              kp[0] = (f32x4){bflo(w.x), bfhi(w.x), bflo(w.y), bfhi(w.y)}; kp[1] = (f32x4){bflo(w.z), bfhi(w.z), bflo(w.w), bfhi(w.w)}; }
#pragma unroll
            for (int s2 = 0; s2 < 2; ++s2) { const int idx = tid + s2 * 512, j = idx >> 4, c16 = idx & 15; const v4u w = *(const GAS v4u*)(Pk + (size_t)j * NIN + 3072 + (hm >> 1) * 128 + 8 * c16); LAS f32x4* vp = (LAS f32x4*)(Vs + j * 128 + 8 * c16);
              vp[0] = (f32x4){bflo(w.x), bfhi(w.x), bflo(w.y), bfhi(w.y)}; vp[1] = (f32x4){bflo(w.z), bfhi(w.z), bflo(w.w), bfhi(w.w)}; }
            __syncthreads();
            const int jmax = (kt == qb) ? qi : 63;
            for (int j = 0; j < 64; ++j) {
                if (j <= jmax) {
                    float sc = 0.f;
#pragma unroll
                    for (int d = 0; d < 64; ++d) sc += q[d] * Ks[j * 64 + d];
                    const float mn = fmaxf(m, sc), corr = __builtin_amdgcn_exp2f(m - mn), p = __builtin_amdgcn_exp2f(sc - mn);
                    l = l * corr + p;
#pragma unroll
                    for (int i = 0; i < 16; ++i) o[i] = o[i] * corr + p * Vs[j * 128 + 16 * ec + i];
                    m = mn;
                }
            }
            __syncthreads();
        }
        const float rl = 1.f / l;
        v4u w0, w1; w0.x = pk2(o[0] * rl, o[1] * rl); w0.y = pk2(o[2] * rl, o[3] * rl); w0.z = pk2(o[4] * rl, o[5] * rl); w0.w = pk2(o[6] * rl, o[7] * rl);
        w1.x = pk2(o[8] * rl, o[9] * rl); w1.y = pk2(o[10] * rl, o[11] * rl); w1.z = pk2(o[12] * rl, o[13] * rl); w1.w = pk2(o[14] * rl, o[15] * rl);
        bf16* op = F.O + ((size_t)b * T + qb * 64 + qi) * 1024 + hm * 128 + 16 * ec;
        *(GAS v4u*)op = w0; *(GAS v4u*)(op + 8) = w1;
    }
}

struct Args { const float* in[16]; float* out; unsigned char* ws; int ph_lo, ph_hi; };
__global__ void __launch_bounds__(NWAVES * 64, 2) hy_fwd(Args args) {
    extern __shared__ __attribute__((aligned(16))) unsigned char lds[];
    Frame F;
    F.lds = (LAS unsigned char*)lds;
    F.MISC = (volatile LAS unsigned*)(F.lds + MISC_OFF);
    F.tid = threadIdx.x; F.lane = F.tid & 63; F.wave = __builtin_amdgcn_readfirstlane(F.tid >> 6);
    F.G = gridDim.x; { const int bx = blockIdx.x; F.vcu = (F.G % 8 == 0) ? (bx % 8) * (F.G / 8) + bx / 8 : bx; }
    unsigned char* ws = args.ws;
    F.ctl = (gu32*)(ws + WS_CTL);
    F.x = args.in[0]; F.g1 = args.in[1]; F.w_in = args.in[2]; F.retg = args.in[3]; F.gq = args.in[4]; F.gk = args.in[5]; F.lq1 = args.in[6]; F.lk1 = args.in[7];
    F.lq2 = args.in[8]; F.lk2 = args.in[9]; F.gsub = args.in[10]; F.w_out = args.in[11]; F.g2 = args.in[12]; F.w_gate = args.in[13]; F.w_up = args.in[14]; F.w_down = args.in[15];
    F.out = args.out;
    F.Win_t = (bf16*)(ws + WS_WIN); F.Wout_t = (bf16*)(ws + WS_WOUT); F.Wgu_t = (bf16*)(ws + WS_WGU); F.Wdn_t = (bf16*)(ws + WS_WDN);
    F.ropec = (float*)(ws + WS_ROPEC); F.ropes = (float*)(ws + WS_ROPES); F.rstd1 = (float*)(ws + WS_RSTD1); F.ss2 = (float*)(ws + WS_SS2); F.KV = (float*)(ws + WS_KV);
    F.XN = (bf16*)(ws + WS_XN); F.P = (bf16*)(ws + WS_P); F.HB = (bf16*)(ws + WS_H); F.O = (bf16*)(ws + WS_O); F.MIX = (bf16*)(ws + WS_MIX);
    for (int u = F.tid; u < (LDS_BYTES - LDSCTL_OFF) / 4; u += NWAVES * 64) ((LAS unsigned*)(F.lds + LDSCTL_OFF))[u] = 0u;
    __syncthreads();
    const int lo = args.ph_lo, hi = args.ph_hi;
    XcdBarrier bar; bar.bar = (unsigned*)(F.ctl + CW_BAR); bar.x = 0; bar.st = nullptr;
    if (hi - lo > 1) bar = xcd_barrier_post((unsigned*)(F.ctl + CW_BAR), F.MISC + 8);
#define IN(k) (lo <= (k) && (k) < hi)
#define BOTH(k) (IN(k) && IN((k) + 1))
#define GRID_BAR() xcd_barrier(bar)

    if (IN(0)) { p0_prologue(F); if (BOTH(0)) GRID_BAR(); }
    if (IN(1)) {
        pg8::Gemm g{F.XN, F.Win_t, M, NIN, D}; pg8::StaticOrder S; S.init(M, NIN, F.G, (int)blockIdx.x);
        LAS float* rs1 = (LAS float*)(F.lds + LDSCTL_OFF + 512);
        const int row0 = 2048 * ((int)blockIdx.x & 7);
        for (int r = F.tid; r < 2048; r += NWAVES * 64) rs1[r] = F.rstd1[row0 + r];
        __syncthreads();
        pg8::EpiIn E{F.P, F.rstd1, F.ropec, F.ropes, F.gq, F.gk, rs1, row0};
        pg8::gemm_phase<pg8::EpiIn, pg8::StaticOrder, true, true>(F.lds + RING_OFF, g, S, E);
        p0_deferred(F);
        if (BOTH(1)) GRID_BAR();
    }
    if (IN(2)) { for (int u = F.vcu; u < 256; u += F.G) ret_state_unit(F, u >> 4, u & 15); }
    if (IN(3)) {
        const attn_body::AttnTensors AT{(const attn_body::bf16*)F.P, (attn_body::bf16*)F.O};
        float gqm = fabsf(F.gq[F.lane]), gkm = fabsf(F.gk[F.lane]);
#pragma unroll
        for (int o = 1; o < 64; o <<= 1) { gqm = fmaxf(gqm, __shfl_xor(gqm, o)); gkm = fmaxf(gkm, __shfl_xor(gkm, o)); }
        const bool bounded = __builtin_amdgcn_readfirstlane((int)(64.f * attn_body::C2 * gqm * gkm < 100.f)) != 0;
        if (bounded) { const attn_body::StaticOrder2 S2((int)F.G, (int)blockIdx.x); attn_body::attn_phase2((char*)lds + RING_OFF, AT, S2); }
        else attn_fallback(F);
        if (BOTH(3)) GRID_BAR();
    }
    if (IN(4)) {
        { for (int u = F.vcu; u < 256; u += F.G) ret_unit(F, u >> 4, u & 15); }
        difmix_rows(F);
        if (BOTH(4)) GRID_BAR();
    }
    if (IN(5)) {
        pg8::Gemm g{F.MIX, F.Wout_t, M, D, D}; pg8::StaticOrder S; S.init(M, D, F.G, (int)blockIdx.x);
        pg8::EpiOut E{F.x, F.XN, F.ss2};
        pg8::gemm_phase<pg8::EpiOut, pg8::StaticOrder, true, true>(F.lds + RING_OFF, g, S, E);
        if (BOTH(5)) GRID_BAR();
    }
    if (IN(6)) {
        pg8::Gemm g{F.XN, F.Wgu_t, M, NGU, D}; pg8::StaticOrder S; S.init(M, NGU, F.G, (int)blockIdx.x);
        LAS float* rs2 = (LAS float*)(F.lds + LDSCTL_OFF + 512);
        const int row0 = 2048 * ((int)blockIdx.x & 7);
        for (int r = F.tid; r < 2048; r += NWAVES * 64) { const f32x4* sp = (const f32x4*)(F.ss2 + (size_t)(row0 + r) * 16); const f32x4 sa = sp[0] + sp[1] + sp[2] + sp[3];
            rs2[r] = rsqrtf(((sa[0] + sa[1]) + (sa[2] + sa[3])) * (1.f / 1024.f) + EPSN); }
        __syncthreads();
        pg8::EpiGU E{F.HB, F.ss2, rs2, row0};
        pg8::gemm_phase<pg8::EpiGU, pg8::StaticOrder, true, true>(F.lds + RING_OFF, g, S, E);
        if (BOTH(6)) GRID_BAR();
    }
    if (IN(7)) {
        pg8::Gemm g{F.HB, F.Wdn_t, M, D, FF}; pg8::StaticOrder S; S.init(M, D, F.G, (int)blockIdx.x);
        pg8::EpiDown E{F.XN, F.out};
        pg8::gemm_phase<pg8::EpiDown, pg8::StaticOrder, true, true>(F.lds + RING_OFF, g, S, E);
    }
#undef IN
#undef BOTH
#undef GRID_BAR
}

extern "C" void kernel_launch(void* const* d_in, const int* in_sizes, int n_in, void* d_out, int out_size, void* d_ws, size_t ws_size, hipStream_t stream) {
    static int grid = 0;
    if (grid == 0) {
        if (n_in != 16 || in_sizes[0] != M * D || out_size != M * D || ws_size < WS_END) { fprintf(stderr, "kernel_launch: unexpected shapes (n_in %d, in0 %d, out %d, ws %zu); nothing launched\n", n_in, n_in > 0 ? in_sizes[0] : -1, out_size, ws_size); grid = -1; return; }
        int dev = 0, cus = 0, per_cu = 0;
        if (hipGetDevice(&dev) != hipSuccess || hipDeviceGetAttribute(&cus, hipDeviceAttributeMultiprocessorCount, dev) != hipSuccess) { grid = -1; return; }
        if (hipFuncSetAttribute((const void*)hy_fwd, hipFuncAttributeMaxDynamicSharedMemorySize, LDS_BYTES) != hipSuccess) { fprintf(stderr, "kernel_launch: hipFuncSetAttribute failed\n"); grid = -1; return; }
        if (hipOccupancyMaxActiveBlocksPerMultiprocessor(&per_cu, (const void*)hy_fwd, NWAVES * 64, LDS_BYTES) != hipSuccess || per_cu < 1) fprintf(stderr, "kernel_launch: note: occupancy query reports %d workgroups per CU\n", per_cu);
        (void)hipGetLastError();
        grid = cus;
        if (grid != 256) fprintf(stderr, "kernel_launch: %d CUs; the phase programs assume 256\n", grid);
    }
    if (grid < 0) return;
    if (hipMemsetAsync((char*)d_ws + WS_CTL, 0, CTL_ZERO_BYTES, stream) != hipSuccess) return;
    Args a{};
    for (int i = 0; i < 16; ++i) a.in[i] = (const float*)d_in[i];
    a.out = (float*)d_out; a.ws = (unsigned char*)d_ws;
    a.ph_lo = 0; a.ph_hi = PER_PHASE;
    hipLaunchKernelGGL(hy_fwd, dim3(grid), dim3(NWAVES * 64), LDS_BYTES, stream, a);
}
```
